# Optimizing an MI355X kernel written in HIP

```python
import math
import jax, jax.numpy as jnp
from jax import lax
import numpy as np

D_MODEL = 2048
BATCH = 32
SEQ = 256
DEPTH = 2
DEC_BATCH = 2
DEC_SEQ = 2048
PAST_LEN = 512

GRID_W = 64
HEAD_DIM = 128
N_HEADS = D_MODEL // HEAD_DIM
HA = N_HEADS // 2
DIFF_HD = HEAD_DIM // 2
DIFF_VD = HEAD_DIM
HB = N_HEADS // 2
GLA_DK = HEAD_DIM // 2
GLA_DV = HEAD_DIM
GLA_GATE_RANK = 16
GLA_TAU = 16.0
GLA_CHUNK = 64
KV_HEADS = N_HEADS // 4
Q_PER_KV = N_HEADS // KV_HEADS
WINDOW = 128
Q_BLOCK = 128
D_FF = -(-8 * D_MODEL // (3 * 256)) * 256
N_EVEN = (DEPTH + 1) // 2
N_ODD = DEPTH // 2
ROPE_BASE = 10000.0
EPS = 1e-6
NEG_INF = -1e30
EVEN_WIDTHS = (HA * 2 * DIFF_HD, HA * 2 * DIFF_HD, HA * DIFF_VD, HB * GLA_DK, HB * GLA_DK, HB * GLA_DV, HB * GLA_DV)
EVEN_SPLITS = tuple(int(s) for s in np.cumsum(EVEN_WIDTHS)[:-1])
EVEN_IN = sum(EVEN_WIDTHS)
EVEN_MIX = HA * DIFF_VD + HB * GLA_DV
ODD_IN = (N_HEADS + 2 * KV_HEADS) * HEAD_DIM
ODD_SPLITS = (N_HEADS * HEAD_DIM, (N_HEADS + KV_HEADS) * HEAD_DIM)
F32 = jnp.float32

kernel_name = 'hybrid_diffusion_prefix_step'


def rms_norm(x, g):
    xf = x.astype(F32)
    y = xf * lax.rsqrt(jnp.mean(xf * xf, axis=-1, keepdims=True) + EPS)
    return (y * g.astype(F32)).astype(x.dtype)


def modulate(h, shift, scale):
    return h * (1 + scale) + shift


def adaln_params(cvec, w, b):
    mod = jax.nn.silu(cvec) @ w + b
    return jnp.split(mod[:, None, :], 6, axis=-1)


def swiglu(h, w_in, w_out):
    gate, up = jnp.split(h @ w_in, 2, axis=-1)
    return (jax.nn.silu(gate) * up) @ w_out


def grid_angles(n_tok, rot_dim):
    rows = n_tok // GRID_W
    t = jnp.arange(rows * GRID_W)
    row = (t // GRID_W).astype(F32)
    col = (t % GRID_W).astype(F32)
    half = rot_dim // 2
    inv = ROPE_BASE ** (-jnp.arange(0, half, 2, dtype=F32) / half)
    return row[:, None] * inv[None], col[:, None] * inv[None]


def rotate(x, ang):
    shape = (1, ang.shape[0]) + (1,) * (x.ndim - 3) + (ang.shape[1],)
    cos = jnp.cos(ang).reshape(shape)
    sin = jnp.sin(ang).reshape(shape)
    x1, x2 = jnp.split(x, 2, axis=-1)
    return jnp.concatenate([x1 * cos - x2 * sin, x2 * cos + x1 * sin], axis=-1)


def axial_rope(x, ang):
    ang_row, ang_col = ang
    xr, xc = jnp.split(x.astype(F32), 2, axis=-1)
    return jnp.concatenate([rotate(xr, ang_row), rotate(xc, ang_col)], axis=-1).astype(x.dtype)


def softmax_with_sink(s, sink):
    sink = jnp.broadcast_to(sink.astype(F32), s.shape[:-1] + (1,))
    return jax.nn.softmax(jnp.concatenate([sink, s], axis=-1), axis=-1)[..., 1:]


def diff_lambda(lq1, lk1, lq2, lk2, lam_init):
    return (jnp.exp(jnp.sum(lq1.astype(F32) * lk1.astype(F32)))
            - jnp.exp(jnp.sum(lq2.astype(F32) * lk2.astype(F32))) + lam_init)


def diff_attention(q, k, v, lam):
    B, Lq = q.shape[0], q.shape[1]
    nb = Lq // Q_BLOCK
    qb = jnp.moveaxis(q.reshape((B, nb, Q_BLOCK) + q.shape[2:]), 1, 0)
    scale = DIFF_HD ** -0.5

    def one(qblk):
        s = jnp.einsum('bqhmd,bkhmd->bhmqk', qblk, k, preferred_element_type=F32) * scale
        p = jax.nn.softmax(s, axis=-1)
        w = p[:, :, 0] - lam * p[:, :, 1]
        return jnp.einsum('bhqk,bkhd->bqhd', w.astype(v.dtype), v)

    o = lax.map(one, qb)
    return jnp.moveaxis(o, 0, 1).reshape(B, Lq, HA, DIFF_VD)


def gla_chunked(q, k, v, g, s0):
    B, L, H, _ = q.shape
    DV = v.shape[-1]
    n = L // GLA_CHUNK

    def chunks(t):
        return jnp.swapaxes(t.reshape(B, n, GLA_CHUNK, H, t.shape[-1]), 2, 3)

    qc, kc, vc, gc = chunks(q), chunks(k), chunks(v), chunks(g)
    b = jnp.cumsum(gc, axis=3)
    b_last = b[:, :, :, -1:, :]
    q_in = qc * jnp.exp(b)
    k_in = kc * jnp.exp(-b)
    k_end = kc * jnp.exp(b_last - b)
    lower = jnp.tril(jnp.ones((GLA_CHUNK, GLA_CHUNK), dtype=bool))
    a = jnp.where(lower, jnp.einsum('bnhid,bnhjd->bnhij', q_in, k_in), 0.0)
    o_intra = jnp.einsum('bnhij,bnhjv->bnhiv', a, vc)
    kv = jnp.einsum('bnhjd,bnhjv->bnhdv', k_end, vc)
    decay = jnp.exp(b_last[:, :, :, 0, :])

    def step(s, inp):
        dec, kv_n = inp
        return dec[..., None] * s + kv_n, s

    s_fin, s_prev = lax.scan(step, s0, (jnp.moveaxis(decay, 1, 0), jnp.moveaxis(kv, 1, 0)))
    o_inter = jnp.einsum('bnhid,nbhdv->bnhiv', q_in, s_prev)
    o = jnp.swapaxes(o_intra + o_inter, 2, 3).reshape(B, L, H, DV)
    return o, s_fin


def bidir_gla(q, k, v, g_f, g_b, s0_f, s0_b):
    o_f, s_f = gla_chunked(q, k, v, g_f, s0_f)
    o_b, s_b = gla_chunked(jnp.flip(q, 1), jnp.flip(k, 1), jnp.flip(v, 1), jnp.flip(g_b, 1), s0_b)
    return o_f + jnp.flip(o_b, 1), s_f, s_b


def even_projections(h, w_in, wg1, wg2, bg):
    B, L, _ = h.shape
    aq, ak, av, bq, bk, bv, br = jnp.split(h @ w_in, EVEN_SPLITS, axis=-1)
    aq = aq.reshape(B, L, HA, 2, DIFF_HD)
    ak = ak.reshape(B, L, HA, 2, DIFF_HD)
    av = av.reshape(B, L, HA, DIFF_VD)
    bq = bq.reshape(B, L, HB, GLA_DK).astype(F32) * GLA_DK ** -0.5
    bk = bk.reshape(B, L, HB, GLA_DK).astype(F32)
    bv = bv.reshape(B, L, HB, GLA_DV).astype(F32)
    low = jnp.einsum('bld,edr->eblr', h, wg1)
    logit = jnp.einsum('eblr,erk->eblk', low, wg2) + bg[:, None, None, :]
    g = (jax.nn.log_sigmoid(logit.astype(F32)) / GLA_TAU).reshape(2, B, L, HB, GLA_DK)
    return aq, ak, av, bq, bk, bv, br, g


def even_output(o_a, o_b, br, subln_g, gla_g, w_out, lam_init, dtype):
    B, L = o_a.shape[0], o_a.shape[1]
    ya = rms_norm(o_a.astype(F32), subln_g) * (1.0 - lam_init)
    yb = rms_norm(o_b, gla_g) * jax.nn.silu(br.astype(F32).reshape(B, L, HB, GLA_DV))
    y = jnp.concatenate([ya.reshape(B, L, -1), yb.reshape(B, L, -1)], axis=-1).astype(dtype)
    return y @ w_out


def even_context(h, lam, lam_init, w_in, subln_g, wg1, wg2, bg, gla_g, w_out):
    B, L, _ = h.shape
    aq, ak, av, bq, bk, bv, br, g = even_projections(h, w_in, wg1, wg2, bg)
    o_a = diff_attention(aq, ak, av, lam)
    s0 = jnp.zeros((B, HB, GLA_DK, GLA_DV), F32)
    o_b, s_f, s_b = bidir_gla(bq, bk, bv, g[0], g[1], s0, s0)
    out = even_output(o_a, o_b, br, subln_g, gla_g, w_out, lam_init, h.dtype)
    return (out, ak.reshape(B, L, HA, 2 * DIFF_HD), av,
            jnp.stack([s_f, s_b], axis=1).astype(h.dtype))


def even_latent(h, ak_ctx, av_ctx, s_ctx, ang, lam, lam_init, w_in, subln_g, wg1, wg2, bg, gla_g, w_out):
    B, L, _ = h.shape
    P = ak_ctx.shape[1]
    aq, ak, av, bq, bk, bv, br, g = even_projections(h, w_in, wg1, wg2, bg)
    aq = axial_rope(aq, ang)
    ak = axial_rope(ak, ang)
    k_all = jnp.concatenate([ak_ctx.reshape(B, P, HA, 2, DIFF_HD).astype(ak.dtype), ak], axis=1)
    v_all = jnp.concatenate([av_ctx.astype(av.dtype), av], axis=1)
    o_a = diff_attention(aq, k_all, v_all, lam)
    sf = s_ctx.astype(F32)
    o_b, _, _ = bidir_gla(bq, bk, bv, g[0], g[1], sf[:, 0], sf[:, 1])
    return even_output(o_a, o_b, br, subln_g, gla_g, w_out, lam_init, h.dtype)


def odd_projections(h, w_in):
    B, L, _ = h.shape
    q, k, v = jnp.split(h @ w_in, ODD_SPLITS, axis=-1)
    return (q.reshape(B, L, N_HEADS, HEAD_DIM), k.reshape(B, L, KV_HEADS, HEAD_DIM),
            v.reshape(B, L, KV_HEADS, HEAD_DIM))


def gqa_sink_dense(q, k, v, sink):
    B, Lq = q.shape[0], q.shape[1]
    nb = Lq // Q_BLOCK
    qb = jnp.moveaxis(q.reshape(B, nb, Q_BLOCK, KV_HEADS, Q_PER_KV, HEAD_DIM), 1, 0)
    sink_l = sink.reshape(KV_HEADS, Q_PER_KV)[None, :, :, None, None]
    scale = HEAD_DIM ** -0.5

    def one(qblk):
        s = jnp.einsum('bqkgd,bskd->bkgqs', qblk, k, preferred_element_type=F32) * scale
        p = softmax_with_sink(s, sink_l)
        return jnp.einsum('bkgqs,bskd->bqkgd', p.astype(v.dtype), v)

    o = lax.map(one, qb)
    return jnp.moveaxis(o, 0, 1).reshape(B, Lq, N_HEADS, HEAD_DIM)


def window_gqa_sink(q, k, v, kc, vc, sink):
    B, L = q.shape[0], q.shape[1]
    P = kc.shape[1]
    nb = L // WINDOW
    qg = q.reshape(B, nb, WINDOW, KV_HEADS, Q_PER_KV, HEAD_DIM)
    pad = ((0, 0), (WINDOW, WINDOW), (0, 0), (0, 0))
    kp = jnp.pad(k, pad)
    vp = jnp.pad(v, pad)
    idx = jnp.arange(nb)[:, None] * WINDOW + jnp.arange(3 * WINDOW)[None, :]
    kb = kp[:, idx]
    vb = vp[:, idx]
    qpos = jnp.arange(nb)[:, None] * WINDOW + jnp.arange(WINDOW)[None, :]
    kpos = idx - WINDOW
    valid = ((jnp.abs(qpos[:, :, None] - kpos[:, None, :]) <= WINDOW)
             & (kpos[:, None, :] >= 0) & (kpos[:, None, :] < L))
    scale = HEAD_DIM ** -0.5
    s_w = jnp.einsum('bnqkgd,bnskd->bnkgqs', qg, kb, preferred_element_type=F32) * scale
    s_w = jnp.where(valid[None, :, None, None], s_w, NEG_INF)
    s_c = jnp.einsum('bnqkgd,bpkd->bnkgqp', qg, kc.astype(q.dtype), preferred_element_type=F32) * scale
    p = softmax_with_sink(jnp.concatenate([s_c, s_w], axis=-1),
                          sink.reshape(KV_HEADS, Q_PER_KV)[None, None, :, :, None, None])
    p_c = p[..., :P].astype(v.dtype)
    p_w = p[..., P:].astype(v.dtype)
    o = (jnp.einsum('bnkgqp,bpkd->bnqkgd', p_c, vc.astype(v.dtype))
         + jnp.einsum('bnkgqs,bnskd->bnqkgd', p_w, vb))
    return o.reshape(B, L, N_HEADS, HEAD_DIM)


def odd_context(h, w_in, sink, w_out):
    B, L, _ = h.shape
    q, k, v = odd_projections(h, w_in)
    o = gqa_sink_dense(q, k, v, sink)
    return o.reshape(B, L, N_HEADS * HEAD_DIM) @ w_out, k, v


def odd_latent(h, kc, vc, ang, w_in, sink, w_out):
    B, L, _ = h.shape
    q, k, v = odd_projections(h, w_in)
    q = axial_rope(q, ang)
    k = axial_rope(k, ang)
    o = window_gqa_sink(q, k, v, kc, vc, sink)
    return o.reshape(B, L, N_HEADS * HEAD_DIM) @ w_out


def setup_inputs(seed: int = 0) -> dict:
    key = jax.random.key(seed)
    ks = iter(jax.random.split(key, 32))

    def nrm(shape, scale=1.0):
        return jax.random.normal(next(ks), shape, F32) * scale

    def gain(shape):
        return 1.0 + 0.02 * jax.random.normal(next(ks), shape, F32)

    return {
        'x_prompt': nrm((BATCH, SEQ, D_MODEL)),
        'x_sample': nrm((DEC_BATCH, DEC_SEQ, D_MODEL)),
        'c': nrm((DEC_BATCH, D_MODEL)),
        'cache_a_k': nrm((DEC_BATCH, N_EVEN, PAST_LEN, HA, 2 * DIFF_HD)),
        'cache_a_v': nrm((DEC_BATCH, N_EVEN, PAST_LEN, HA, DIFF_VD)),
        'state_b': nrm((DEC_BATCH, N_EVEN, 2, HB, GLA_DK, GLA_DV)),
        'cache_c_k': nrm((DEC_BATCH, N_ODD, PAST_LEN, KV_HEADS, HEAD_DIM)),
        'cache_c_v': nrm((DEC_BATCH, N_ODD, PAST_LEN, KV_HEADS, HEAD_DIM)),
        'c_ctx': nrm((D_MODEL,)),
        'w_ada': nrm((DEPTH, D_MODEL, 6 * D_MODEL), 0.5 * D_MODEL ** -0.5),
        'b_ada': nrm((DEPTH, 6 * D_MODEL), 0.01),
        'norm_g': gain((DEPTH, 2, D_MODEL)),
        'w_in_even': nrm((N_EVEN, D_MODEL, EVEN_IN), D_MODEL ** -0.5),
        'lam_q1': nrm((N_EVEN, DIFF_HD), 0.1),
        'lam_k1': nrm((N_EVEN, DIFF_HD), 0.1),
        'lam_q2': nrm((N_EVEN, DIFF_HD), 0.1),
        'lam_k2': nrm((N_EVEN, DIFF_HD), 0.1),
        'subln_g': gain((N_EVEN, DIFF_VD)),
        'w_gate1': nrm((N_EVEN, 2, D_MODEL, GLA_GATE_RANK), D_MODEL ** -0.5),
        'w_gate2': nrm((N_EVEN, 2, GLA_GATE_RANK, HB * GLA_DK), GLA_GATE_RANK ** -0.5),
        'b_gate': nrm((N_EVEN, 2, HB * GLA_DK), 0.1),
        'gla_norm_g': gain((N_EVEN, GLA_DV)),
        'w_out_even': nrm((N_EVEN, EVEN_MIX, D_MODEL), EVEN_MIX ** -0.5),
        'w_in_odd': nrm((N_ODD, D_MODEL, ODD_IN), D_MODEL ** -0.5),
        'sinks': nrm((N_ODD, N_HEADS)),
        'w_out_odd': nrm((N_ODD, N_HEADS * HEAD_DIM, D_MODEL), (N_HEADS * HEAD_DIM) ** -0.5),
        'w_ffn_in': nrm((DEPTH, D_MODEL, 2 * D_FF), D_MODEL ** -0.5),
        'w_ffn_out': nrm((DEPTH, D_FF, D_MODEL), D_FF ** -0.5),
        'final_norm_g': gain((D_MODEL,)),
    }


def reference(x_prompt, x_sample, c, cache_a_k, cache_a_v, state_b, cache_c_k, cache_c_v, c_ctx,
              w_ada, b_ada, norm_g, w_in_even, lam_q1, lam_k1, lam_q2, lam_k2, subln_g,
              w_gate1, w_gate2, b_gate, gla_norm_g, w_out_even, w_in_odd, sinks, w_out_odd,
              w_ffn_in, w_ffn_out, final_norm_g):
    xp, xs = x_prompt, x_sample
    n_lat = xs.shape[1]
    ang_d = grid_angles(n_lat, DIFF_HD)
    ang_h = grid_angles(n_lat, HEAD_DIM)
    new_a_k, new_a_v, new_s_b, new_c_k, new_c_v = [], [], [], [], []
    for layer in range(DEPTH):
        j = layer // 2
        pm = adaln_params(c_ctx[None, :], w_ada[layer], b_ada[layer])
        sm = adaln_params(c, w_ada[layer], b_ada[layer])
        hp = modulate(rms_norm(xp, norm_g[layer, 0]), pm[0], pm[1])
        hs = modulate(rms_norm(xs, norm_g[layer, 0]), sm[0], sm[1])
        if layer % 2 == 0:
            lam_init = 0.8 - 0.6 * math.exp(-0.3 * layer)
            lam = diff_lambda(lam_q1[j], lam_k1[j], lam_q2[j], lam_k2[j], lam_init)
            mp, ak, av, sb = even_context(hp, lam, lam_init, w_in_even[j], subln_g[j], w_gate1[j],
                                          w_gate2[j], b_gate[j], gla_norm_g[j], w_out_even[j])
            ms = even_latent(hs, cache_a_k[:, j], cache_a_v[:, j], state_b[:, j], ang_d, lam, lam_init,
                             w_in_even[j], subln_g[j], w_gate1[j], w_gate2[j], b_gate[j],
                             gla_norm_g[j], w_out_even[j])
            new_a_k.append(ak)
            new_a_v.append(av)
            new_s_b.append(sb)
        else:
            mp, ck, cv = odd_context(hp, w_in_odd[j], sinks[j], w_out_odd[j])
            ms = odd_latent(hs, cache_c_k[:, j], cache_c_v[:, j], ang_h, w_in_odd[j], sinks[j], w_out_odd[j])
            new_c_k.append(ck)
            new_c_v.append(cv)
        xp = xp + pm[2] * mp
        xs = xs + sm[2] * ms
        xp = xp + pm[5] * swiglu(modulate(rms_norm(xp, norm_g[layer, 1]), pm[3], pm[4]),
                                 w_ffn_in[layer], w_ffn_out[layer])
        xs = xs + sm[5] * swiglu(modulate(rms_norm(xs, norm_g[layer, 1]), sm[3], sm[4]),
                                 w_ffn_in[layer], w_ffn_out[layer])
    y_prompt = rms_norm(xp, final_norm_g)
    y_sample = rms_norm(xs, final_norm_g)
    return (y_prompt, y_sample, jnp.stack(new_a_k, axis=1), jnp.stack(new_a_v, axis=1),
            jnp.stack(new_s_b, axis=1), jnp.stack(new_c_k, axis=1), jnp.stack(new_c_v, axis=1))
```

```cpp
#include <hip/hip_runtime.h>
#include <hip/hip_cooperative_groups.h>
#include <stdint.h>
#include <cstdio>
namespace cg = cooperative_groups;

typedef unsigned short bf16_t;
using bf16x8 = __attribute__((ext_vector_type(8))) short;
using s16x4  = __attribute__((ext_vector_type(4))) short;
using f32x16 = __attribute__((ext_vector_type(16))) float;
using u32x4  = __attribute__((ext_vector_type(4))) unsigned;
using f32x4  = __attribute__((ext_vector_type(4))) float;
#define MFMA16(a, b, c) __builtin_amdgcn_mfma_f32_16x16x32_bf16((a), (b), (c), 0, 0, 0)
#define DI __device__ __forceinline__
#define LAS __attribute__((address_space(3)))
#define MFMA32(a, b, c) __builtin_amdgcn_mfma_f32_32x32x16_bf16((a), (b), (c), 0, 0, 0)

constexpr int D = 2048;
constexpr int NP = 8192;
constexpr int NL = 4096;
constexpr int NTOK = NP + NL;
constexpr int LSEQ = 2048;
constexpr int PSEQ = 256;
constexpr int PAST = 512;
constexpr int DFF = 5632;
constexpr int EIN = 6144;
constexpr int EINP = 6272;
constexpr int OIN = 3072;
constexpr int MODW = 6 * D;
constexpr int DP = D + 64;
constexpr int FP = DFF + 64;
constexpr int LP = LSEQ + 64;

constexpr size_t al256(size_t x) { return (x + 255) & ~(size_t)255; }
constexpr size_t OFF_MOD   = 0;
constexpr size_t OFF_CNT   = OFF_MOD + (size_t)2 * 3 * MODW * 4;
constexpr size_t OFF_BAR   = OFF_CNT + 256;
constexpr size_t ZERO_BYTES = OFF_BAR + 3456 * 4;
constexpr size_t OFF_MISC  = ZERO_BYTES;
constexpr size_t OFF_ROPE  = OFF_MISC + 256;
constexpr size_t OFF_WIE   = al256(OFF_ROPE + (size_t)(64 * 16 * 2 + 64 * 32 * 2) * 4);
constexpr size_t OFF_WOE   = OFF_WIE + (size_t)EINP * DP * 2;
constexpr size_t OFF_WIO   = OFF_WOE + (size_t)D * DP * 2;
constexpr size_t OFF_WOO   = OFF_WIO + (size_t)OIN * DP * 2;
constexpr size_t OFF_WFI   = OFF_WOO + (size_t)D * DP * 2;
constexpr size_t OFF_WFO   = OFF_WFI + (size_t)2 * 2 * DFF * DP * 2;
constexpr size_t OFF_X     = OFF_WFO + (size_t)2 * D * FP * 2;
constexpr size_t OFF_H     = OFF_X + (size_t)NTOK * D * 4;
constexpr size_t OFF_P     = OFF_H + (size_t)NTOK * DP * 2;
constexpr size_t OFF_ACT   = OFF_P + (size_t)NTOK * EINP * 2;
constexpr size_t OFF_OD    = OFF_ACT;
constexpr size_t OFF_BVTP  = OFF_OD + (size_t)NTOK * 2 * 1024 * 4;
constexpr size_t OFF_BVTL  = OFF_BVTP + (size_t)256 * 128 * 256 * 2;
constexpr size_t OFF_GO    = OFF_ACT + (size_t)NTOK * FP * 2;
constexpr size_t OFF_VTP   = OFF_GO + (size_t)2 * NTOK * 1024 * 4;
constexpr size_t OFF_VTL   = OFF_VTP + (size_t)256 * 128 * 256 * 2;
constexpr size_t OFF_KCA   = OFF_VTL + (size_t)16 * 128 * LP * 2;
constexpr size_t OFF_VTCA  = OFF_KCA + (size_t)2 * 512 * 1024 * 2;
constexpr size_t OFF_KCC   = OFF_VTCA + (size_t)16 * 128 * 512 * 2;
constexpr size_t OFF_VTCC  = OFF_KCC + (size_t)2 * 512 * 512 * 2;
constexpr size_t OFF_LOW   = OFF_VTCC + (size_t)8 * 128 * 512 * 2;
constexpr size_t WS_TOTAL  = OFF_LOW + (size_t)NTOK * 32 * 4;
static_assert(OFF_BVTL + (size_t)16 * 128 * LP * 2 <= OFF_GO, "alias overflow");

constexpr size_t OUT_YP = 0;
constexpr size_t OUT_YS = OUT_YP + (size_t)NP * D;
constexpr size_t OUT_AK = OUT_YS + (size_t)NL * D;
constexpr size_t OUT_AV = OUT_AK + (size_t)NP * 1024;
constexpr size_t OUT_SB = OUT_AV + (size_t)NP * 1024;
constexpr size_t OUT_CK = OUT_SB + (size_t)32 * 2 * 8 * 64 * 128;
constexpr size_t OUT_CV = OUT_CK + (size_t)NP * 512;

struct Params {
  const float* x_prompt; const float* x_sample; const float* c;
  const float* cache_a_k; const float* cache_a_v; const float* state_b;
  const float* cache_c_k; const float* cache_c_v; const float* c_ctx;
  const float* w_ada; const float* b_ada; const float* norm_g;
  const float* w_in_even; const float* lam_q1; const float* lam_k1; const float* lam_q2; const float* lam_k2;
  const float* subln_g; const float* w_gate1; const float* w_gate2; const float* b_gate; const float* gla_norm_g;
  const float* w_out_even; const float* w_in_odd; const float* sinks; const float* w_out_odd;
  const float* w_ffn_in; const float* w_ffn_out; const float* final_norm_g;
  float* out; char* ws;
  int ph_lo; int ph_hi;
};

constexpr int SMEM_BYTES = 73728;

typedef float f32x2_t __attribute__((ext_vector_type(2)));
typedef __bf16 bf16x2_t __attribute__((ext_vector_type(2)));
DI unsigned pack2(float a, float b) { f32x2_t v = {a, b}; return __builtin_bit_cast(unsigned, __builtin_convertvector(v, bf16x2_t)); }
DI unsigned short f2bf(float x) { return (unsigned short)(pack2(x, 0.f) & 0xffffu); }
DI float bf2f(unsigned short v) { return __uint_as_float(((unsigned)v) << 16); }
DI int opaque_tid() { int t = threadIdx.x; asm volatile("" : "+v"(t)); return t; }
DI int crow(int reg, int h) { return (reg & 3) + 8 * (reg >> 2) + 4 * h; }
DI float wave_sum(float v) {
#pragma unroll
  for (int o = 32; o >= 1; o >>= 1) v += __shfl_xor(v, o, 64);
  return v;
}
DI float half_sum(float v) {
#pragma unroll
  for (int o = 16; o >= 1; o >>= 1) v += __shfl_xor(v, o, 64);
  return v;
}
DI float siluf(float x) { return x * __builtin_amdgcn_rcpf(1.f + __expf(-x)); }
DI int modrow(int m) { return m < NP ? 0 : 1 + ((m - NP) >> 11); }
DI bf16x8 pack8(const f32x16& x, int s) {
  uint4 u;
  u.x = pack2(x[8 * s + 0], x[8 * s + 1]); u.y = pack2(x[8 * s + 2], x[8 * s + 3]);
  u.z = pack2(x[8 * s + 4], x[8 * s + 5]); u.w = pack2(x[8 * s + 6], x[8 * s + 7]);
  return __builtin_bit_cast(bf16x8, u);
}
DI bf16x8 ld_frag16(const char* p) { return *(const bf16x8*)p; }
DI bf16x8 ld_frag8x2(const char* p) {
  s16x4 lo = *(const s16x4*)p; s16x4 hi = *(const s16x4*)(p + 16);
  return __builtin_shufflevector(lo, hi, 0, 1, 2, 3, 4, 5, 6, 7);
}

DI void wt_tile(const float* __restrict__ src, int K, int N, bf16_t* __restrict__ dst, int KP, int k0, int n0, int drow0, char* smem) {
  float* t = (float*)smem;
  const int tid = opaque_tid();
  __syncthreads();
#pragma unroll
  for (int i = 0; i < 4; ++i) {
    int k = (tid >> 4) + 16 * i, n4 = (tid & 15) * 4;
    float4 v = *(const float4*)(src + (size_t)(k0 + k) * N + n0 + n4);
    t[k * 65 + n4 + 0] = v.x; t[k * 65 + n4 + 1] = v.y; t[k * 65 + n4 + 2] = v.z; t[k * 65 + n4 + 3] = v.w;
  }
  __syncthreads();
#pragma unroll
  for (int i = 0; i < 2; ++i) {
    int c = tid + 256 * i, n = c >> 3, kg = c & 7;
    uint4 u;
    u.x = pack2(t[(kg * 8 + 0) * 65 + n], t[(kg * 8 + 1) * 65 + n]);
    u.y = pack2(t[(kg * 8 + 2) * 65 + n], t[(kg * 8 + 3) * 65 + n]);
    u.z = pack2(t[(kg * 8 + 4) * 65 + n], t[(kg * 8 + 5) * 65 + n]);
    u.w = pack2(t[(kg * 8 + 6) * 65 + n], t[(kg * 8 + 7) * 65 + n]);
    *(uint4*)(dst + (size_t)(drow0 + n) * KP + k0 + kg * 8) = u;
  }
}

DI void adaln_item(const Params& p, int it, char* smem) {
  const int tid = opaque_tid();
  const int l = it / 384, rem = it % 384, cb = rem >> 3, ks = rem & 7;
  float* s = (float*)smem;
  float* red = s + 768;
  __syncthreads();
  for (int i = tid; i < 768; i += 256) {
    int r = i >> 8, k = ks * 256 + (i & 255);
    float cv = (r == 0) ? p.c_ctx[k] : p.c[(r - 1) * D + k];
    s[i] = siluf(cv);
  }
  __syncthreads();
  const int cg4 = tid & 63, kq = tid >> 6;
  const float* W = p.w_ada + (size_t)l * D * MODW + (size_t)(ks * 256 + kq * 64) * MODW + cb * 256 + cg4 * 4;
  float a0[4] = {0, 0, 0, 0}, a1[4] = {0, 0, 0, 0}, a2[4] = {0, 0, 0, 0};
#pragma unroll 8
  for (int k = 0; k < 64; ++k) {
    float4 w = *(const float4*)(W + (size_t)k * MODW);
    float s0 = s[kq * 64 + k], s1 = s[256 + kq * 64 + k], s2 = s[512 + kq * 64 + k];
    a0[0] += s0 * w.x; a0[1] += s0 * w.y; a0[2] += s0 * w.z; a0[3] += s0 * w.w;
    a1[0] += s1 * w.x; a1[1] += s1 * w.y; a1[2] += s1 * w.z; a1[3] += s1 * w.w;
    a2[0] += s2 * w.x; a2[1] += s2 * w.y; a2[2] += s2 * w.z; a2[3] += s2 * w.w;
  }
#pragma unroll
  for (int j = 0; j < 4; ++j) {
    red[(kq * 3 + 0) * 256 + cg4 * 4 + j] = a0[j];
    red[(kq * 3 + 1) * 256 + cg4 * 4 + j] = a1[j];
    red[(kq * 3 + 2) * 256 + cg4 * 4 + j] = a2[j];
  }
  __syncthreads();
  float* mod = (float*)(p.ws + OFF_MOD);
  for (int i = tid; i < 768; i += 256) {
    int r = i >> 8, col = i & 255;
    float v = red[(0 * 3 + r) * 256 + col] + red[(1 * 3 + r) * 256 + col] + red[(2 * 3 + r) * 256 + col] + red[(3 * 3 + r) * 256 + col];
    int n = cb * 256 + col;
    if (ks == 0) v += p.b_ada[l * MODW + n];
    atomicAdd(&mod[(size_t)(l * 3 + r) * MODW + n], v);
  }
}

DI void phase_prep(const Params& p, char* smem) {
  const int G = gridDim.x, bid = blockIdx.x, tid = threadIdx.x;
  char* ws = p.ws;
  for (int it = bid; it < 768; it += G) adaln_item(p, it, smem);
  const int T0 = 3072, T1 = T0 + 1024, T2 = T1 + 1536, T3 = T2 + 1024, T4 = T3 + 5632, T5 = T4 + 5632, T6 = T5 + 2816, T7 = T6 + 2816;
  for (int t = bid; t < T7; t += G) {
    if (t < T0) { int kt = t % 32, nt = t / 32; wt_tile(p.w_in_even, D, EIN, (bf16_t*)(ws + OFF_WIE), DP, kt * 64, nt * 64, nt * 64, smem); }
    else if (t < T1) { int u = t - T0; int kt = u % 32, nt = u / 32; wt_tile(p.w_out_even, D, D, (bf16_t*)(ws + OFF_WOE), DP, kt * 64, nt * 64, nt * 64, smem); }
    else if (t < T2) { int u = t - T1; int kt = u % 32, nt = u / 32; wt_tile(p.w_in_odd, D, OIN, (bf16_t*)(ws + OFF_WIO), DP, kt * 64, nt * 64, nt * 64, smem); }
    else if (t < T3) { int u = t - T2; int kt = u % 32, nt = u / 32; wt_tile(p.w_out_odd, D, D, (bf16_t*)(ws + OFF_WOO), DP, kt * 64, nt * 64, nt * 64, smem); }
    else if (t < T5) {
      int l = (t < T4) ? 0 : 1; int u = t - (l ? T4 : T3); int kt = u % 32, nt = u / 32;
      int drow = (nt < 88) ? nt * 128 : (nt - 88) * 128 + 64;
      wt_tile(p.w_ffn_in + (size_t)l * D * 2 * DFF, D, 2 * DFF, (bf16_t*)(ws + OFF_WFI) + (size_t)l * 2 * DFF * DP, DP, kt * 64, nt * 64, drow, smem);
    } else {
      int l = (t < T6) ? 0 : 1; int u = t - (l ? T6 : T5); int kt = u % 88, nt = u / 88;
      wt_tile(p.w_ffn_out + (size_t)l * DFF * D, DFF, D, (bf16_t*)(ws + OFF_WFO) + (size_t)l * D * FP, FP, kt * 64, nt * 64, nt * 64, smem);
    }
  }
  const size_t gt = (size_t)bid * 256 + tid, gs = (size_t)G * 256;
  {
    bf16_t* d = (bf16_t*)(ws + OFF_KCA);
    for (size_t i = gt; i < (size_t)2 * 512 * 1024; i += gs) d[i] = f2bf(p.cache_a_k[i]);
    bf16_t* d2 = (bf16_t*)(ws + OFF_KCC);
    for (size_t i = gt; i < (size_t)2 * 512 * 512; i += gs) d2[i] = f2bf(p.cache_c_k[i]);
  }
  {
    bf16_t* d = (bf16_t*)(ws + OFF_VTCA);
    for (size_t i = gt; i < (size_t)2 * 512 * 1024; i += gs) {
      int dv = i & 127, h = (i >> 7) & 7, tok = (i >> 10) & 511, b = (int)(i >> 19);
      d[((size_t)(b * 8 + h) * 128 + dv) * 512 + tok] = f2bf(p.cache_a_v[i]);
    }
    bf16_t* d2 = (bf16_t*)(ws + OFF_VTCC);
    for (size_t i = gt; i < (size_t)2 * 512 * 512; i += gs) {
      int dv = i & 127, h = (i >> 7) & 3, tok = (i >> 9) & 511, b = (int)(i >> 18);
      d2[((size_t)(b * 4 + h) * 128 + dv) * 512 + tok] = f2bf(p.cache_c_v[i]);
    }
  }
  {
    bf16_t* d = (bf16_t*)(ws + OFF_WIE);
    for (size_t i = gt; i < (size_t)2 * D * 16; i += gs) {
      int r = i & 15, dd = (i >> 4) & 2047, e = (int)(i >> 15);
      d[(size_t)(EIN + e * 16 + r) * DP + dd] = f2bf(p.w_gate1[i]);
    }
    for (size_t i = gt; i < (size_t)96 * DP; i += gs) d[(size_t)(EIN + 32) * DP + i] = 0;
  }
  {
    float* rt = (float*)(ws + OFF_ROPE);
    for (size_t i = gt; i < 64 * 16; i += gs) {
      int f = i & 15, pos = (int)(i >> 4);
      float inv = powf(10000.f, -(float)(2 * f) / 32.f);
      float a = (float)pos * inv;
      rt[i] = cosf(a); rt[1024 + i] = sinf(a);
    }
    for (size_t i = gt; i < 64 * 32; i += gs) {
      int f = i & 31, pos = (int)(i >> 5);
      float inv = powf(10000.f, -(float)(2 * f) / 64.f);
      float a = (float)pos * inv;
      rt[2048 + i] = cosf(a); rt[2048 + 2048 + i] = sinf(a);
    }
  }
  if (bid == 0 && tid < 64) {
    float a = p.lam_q1[tid] * p.lam_k1[tid], b = p.lam_q2[tid] * p.lam_k2[tid];
    a = wave_sum(a); b = wave_sum(b);
    if (tid == 0) ((float*)(ws + OFF_MISC))[0] = expf(a) - expf(b) + 0.2f;
  }
}

DI void phase_norm(const Params& p, int layer, int which, bool from_input, bool final_norm) {
  const int lane = threadIdx.x & 63, w = threadIdx.x >> 6;
  const float* mod = (const float*)(p.ws + OFF_MOD);
  const bf16_t* Xb = (const bf16_t*)(p.ws + OFF_X);
  bf16_t* H = (bf16_t*)(p.ws + OFF_H);
  const float* g = final_norm ? p.final_norm_g : (p.norm_g + (size_t)(layer * 2 + which) * D);
  float4 ca[8], cb[8];
  int rcur = -1;
  for (int m = blockIdx.x * 4 + w; m < NTOK; m += gridDim.x * 4) {
    const float* x = (m < NP) ? p.x_prompt + (size_t)m * D : p.x_sample + (size_t)(m - NP) * D;
    float4 v[8];
    float ss = 0.f;
#pragma unroll
    for (int i = 0; i < 4; ++i) {
      const int k = (lane + 64 * i) * 8;
      if (from_input) { v[2 * i] = *(const float4*)(x + k); v[2 * i + 1] = *(const float4*)(x + k + 4); }
      else { const uint4 u = *(const uint4*)(Xb + (size_t)m * D + k);
        v[2 * i].x = bf2f(u.x & 0xffff); v[2 * i].y = bf2f(u.x >> 16); v[2 * i].z = bf2f(u.y & 0xffff); v[2 * i].w = bf2f(u.y >> 16);
        v[2 * i + 1].x = bf2f(u.z & 0xffff); v[2 * i + 1].y = bf2f(u.z >> 16); v[2 * i + 1].z = bf2f(u.w & 0xffff); v[2 * i + 1].w = bf2f(u.w >> 16); }
    }
#pragma unroll
    for (int j = 0; j < 8; ++j) ss += v[j].x * v[j].x + v[j].y * v[j].y + v[j].z * v[j].z + v[j].w * v[j].w;
    const int rnew = final_norm ? 0 : modrow(m);
    if (rnew != rcur) {
      rcur = rnew;
      const float* mr = mod + (size_t)(layer * 3 + rnew) * MODW + which * 3 * D;
#pragma unroll
      for (int j = 0; j < 8; ++j) {
        const int k = (lane + 64 * (j >> 1)) * 8 + (j & 1) * 4;
        const float4 gg = *(const float4*)(g + k);
        if (final_norm) { ca[j] = gg; cb[j] = make_float4(0.f, 0.f, 0.f, 0.f); }
        else {
          const float4 sh = *(const float4*)(mr + k);
          const float4 sc = *(const float4*)(mr + D + k);
          ca[j].x = gg.x * (1.f + sc.x); ca[j].y = gg.y * (1.f + sc.y); ca[j].z = gg.z * (1.f + sc.z); ca[j].w = gg.w * (1.f + sc.w);
          cb[j] = sh;
        }
      }
    }
    ss = wave_sum(ss);
    const float rstd = rsqrtf(ss * (1.f / D) + 1e-6f);
    if (final_norm) {
      float* o = p.out + (size_t)m * D;
#pragma unroll
      for (int j = 0; j < 8; ++j) {
        const int k = (lane + 64 * (j >> 1)) * 8 + (j & 1) * 4;
        float4 r; r.x = v[j].x * rstd * ca[j].x; r.y = v[j].y * rstd * ca[j].y; r.z = v[j].z * rstd * ca[j].z; r.w = v[j].w * rstd * ca[j].w;
        *(float4*)(o + k) = r;
      }
    } else {
#pragma unroll
      for (int i = 0; i < 4; ++i) {
        const int k = (lane + 64 * i) * 8;
        uint4 u;
        u.x = pack2(v[2 * i].x * rstd * ca[2 * i].x + cb[2 * i].x, v[2 * i].y * rstd * ca[2 * i].y + cb[2 * i].y);
        u.y = pack2(v[2 * i].z * rstd * ca[2 * i].z + cb[2 * i].z, v[2 * i].w * rstd * ca[2 * i].w + cb[2 * i].w);
        u.z = pack2(v[2 * i + 1].x * rstd * ca[2 * i + 1].x + cb[2 * i + 1].x, v[2 * i + 1].y * rstd * ca[2 * i + 1].y + cb[2 * i + 1].y);
        u.w = pack2(v[2 * i + 1].z * rstd * ca[2 * i + 1].z + cb[2 * i + 1].z, v[2 * i + 1].w * rstd * ca[2 * i + 1].w + cb[2 * i + 1].w);
        *(uint4*)(H + (size_t)m * DP + k) = u;
      }
    }
  }
}

enum { EPI_IN_EVEN = 0, EPI_IN_ODD = 1, EPI_RESID = 2, EPI_SWIGLU = 3 };
constexpr int GA_STRIDE = 144;
constexpr int G_TILE_BYTES = 128 * GA_STRIDE;
constexpr int CS_LD = 132;

struct GemmArgs {
  const bf16_t* A; int lda;
  const bf16_t* Bt; int ldb;
  int K;
  int layer; int which;
  bool x_from_input;
};

DI void rope4(float4& v, const float4& pv, const float* ct, const float* st, int pos, int nf, int f, float sign) {
  const float* c = ct + pos * nf + f; const float* s = st + pos * nf + f;
  v.x = v.x * c[0] + sign * pv.x * s[0];
  v.y = v.y * c[1] + sign * pv.y * s[1];
  v.z = v.z * c[2] + sign * pv.z * s[2];
  v.w = v.w * c[3] + sign * pv.w * s[3];
}

template <int EPI>
DI void gemm_tile(const Params& p, const GemmArgs& ga, int mt, int nt, char* smem) {
  const int tid = opaque_tid(), lane = tid & 63, w = tid >> 6, wm = w >> 1, wn = w & 1;
  const int r = lane & 31, hh = lane >> 5;
  const int m0 = mt * 128, n0 = nt * 128;
  const int K = ga.K, KT = K >> 6;
  const int l15 = lane & 15, quad = lane >> 4;
  f32x4 acc[4][4];
#pragma unroll
  for (int a = 0; a < 4; ++a)
#pragma unroll
    for (int b = 0; b < 4; ++b)
#pragma unroll
      for (int i = 0; i < 4; ++i) acc[a][b][i] = 0.f;

  const int nkt = K >> 6;
  const bf16_t* Asrc[4]; const bf16_t* Bsrc[4];
#pragma unroll
  for (int i = 0; i < 4; ++i) {
    const int c = i * 256 + tid, row = c >> 3, lc = (c & 7) ^ ((row >> 1) & 7);
    Asrc[i] = ga.A + (size_t)(m0 + row) * ga.lda + lc * 8;
    Bsrc[i] = ga.Bt + (size_t)(n0 + row) * ga.ldb + lc * 8;
  }
  const int wbase = __builtin_amdgcn_readfirstlane(w) * 1024;
#define G_STAGE(BUF, KTI) { _Pragma("unroll") for (int i = 0; i < 4; ++i) { \
    __builtin_amdgcn_global_load_lds((const unsigned*)(Asrc[i] + (KTI) * 64), (LAS unsigned*)(smem + (BUF) * 32768 + i * 4096 + wbase), 16, 0, 0); \
    __builtin_amdgcn_global_load_lds((const unsigned*)(Bsrc[i] + (KTI) * 64), (LAS unsigned*)(smem + (BUF) * 32768 + 16384 + i * 4096 + wbase), 16, 0, 0); } }
#define G_WAITV(N) asm volatile("s_waitcnt vmcnt(" #N ")" ::: "memory")
#define G_RAWBAR() { asm volatile("s_waitcnt lgkmcnt(0)" ::: "memory"); __builtin_amdgcn_s_barrier(); }
  int arow[4], brow[4], asw[4], bsw[4];
#pragma unroll
  for (int t = 0; t < 4; ++t) {
    const int ra_ = wm * 64 + t * 16 + l15, rb_ = wn * 64 + t * 16 + l15;
    arow[t] = ra_ * 128; asw[t] = (ra_ >> 1) & 7;
    brow[t] = rb_ * 128 + 16384; bsw[t] = (rb_ >> 1) & 7;
  }
  G_WAITV(0);
  __syncthreads();
  G_STAGE(0, 0);
  G_WAITV(0);
  G_RAWBAR();
  for (int kt = 0; kt < nkt; ++kt) {
    const int cur = kt & 1;
    if (kt + 1 < nkt) G_STAGE(cur ^ 1, kt + 1);
    const char* sS = smem + cur * 32768;
#pragma unroll
    for (int s2 = 0; s2 < 2; ++s2) {
      bf16x8 af[4], bfr[4];
#pragma unroll
      for (int t = 0; t < 4; ++t) {
        af[t] = ld_frag16(sS + arow[t] + (((s2 * 4 + quad) ^ asw[t]) << 4));
        bfr[t] = ld_frag16(sS + brow[t] + (((s2 * 4 + quad) ^ bsw[t]) << 4));
      }
#pragma unroll
      for (int a = 0; a < 4; ++a)
#pragma unroll
        for (int b = 0; b < 4; ++b) acc[a][b] = MFMA16(af[a], bfr[b], acc[a][b]);
    }
    G_WAITV(0);
    G_RAWBAR();
  }
#undef G_STAGE
#undef G_WAITV
#undef G_RAWBAR
  float* Cs = (float*)smem;
#pragma unroll
  for (int a = 0; a < 4; ++a)
#pragma unroll
    for (int b = 0; b < 4; ++b)
#pragma unroll
      for (int i = 0; i < 4; ++i)
        Cs[(wm * 64 + a * 16 + quad * 4 + i) * CS_LD + wn * 64 + b * 16 + l15] = acc[a][b][i];
  __syncthreads();

  if constexpr (EPI == EPI_RESID) {
    const float* mod = (const float*)(p.ws + OFF_MOD);
    bf16_t* Xb = (bf16_t*)(p.ws + OFF_X);
    const int c8 = (tid & 15) * 8;
    const float* gp = mod + (size_t)(ga.layer * 3 + modrow(m0)) * MODW + (ga.which ? 5 : 2) * D + n0 + c8;
    const float4 gt0 = *(const float4*)gp, gt1 = *(const float4*)(gp + 4);
#pragma unroll 4
    for (int ps = 0; ps < 8; ++ps) {
      const int row = ps * 16 + (tid >> 4);
      const int m = m0 + row, n = n0 + c8;
      const float4 v0 = *(const float4*)&Cs[row * CS_LD + c8];
      const float4 v1 = *(const float4*)&Cs[row * CS_LD + c8 + 4];
      float4 x0, x1;
      if (ga.x_from_input) { const float* xp = ((m < NP) ? p.x_prompt + (size_t)m * D : p.x_sample + (size_t)(m - NP) * D) + n;
        x0 = *(const float4*)xp; x1 = *(const float4*)(xp + 4); }
      else { const uint4 u = *(const uint4*)(Xb + (size_t)m * D + n);
        x0.x = bf2f(u.x & 0xffff); x0.y = bf2f(u.x >> 16); x0.z = bf2f(u.y & 0xffff); x0.w = bf2f(u.y >> 16);
        x1.x = bf2f(u.z & 0xffff); x1.y = bf2f(u.z >> 16); x1.z = bf2f(u.w & 0xffff); x1.w = bf2f(u.w >> 16); }
      uint4 o;
      o.x = pack2(x0.x + gt0.x * v0.x, x0.y + gt0.y * v0.y); o.y = pack2(x0.z + gt0.z * v0.z, x0.w + gt0.w * v0.w);
      o.z = pack2(x1.x + gt1.x * v1.x, x1.y + gt1.y * v1.y); o.w = pack2(x1.z + gt1.z * v1.z, x1.w + gt1.w * v1.w);
      *(uint4*)(Xb + (size_t)m * D + n) = o;
    }
  } else if constexpr (EPI == EPI_SWIGLU) {
    bf16_t* act = (bf16_t*)(p.ws + OFF_ACT);
#pragma unroll 4
    for (int ps = 0; ps < 4; ++ps) {
      const int row = ps * 32 + (tid >> 3), j8 = (tid & 7) * 8;
      const float4 g0 = *(const float4*)&Cs[row * CS_LD + j8], g1 = *(const float4*)&Cs[row * CS_LD + j8 + 4];
      const float4 u0 = *(const float4*)&Cs[row * CS_LD + 64 + j8], u1 = *(const float4*)&Cs[row * CS_LD + 64 + j8 + 4];
      uint4 o;
      o.x = pack2(siluf(g0.x) * u0.x, siluf(g0.y) * u0.y); o.y = pack2(siluf(g0.z) * u0.z, siluf(g0.w) * u0.w);
      o.z = pack2(siluf(g1.x) * u1.x, siluf(g1.y) * u1.y); o.w = pack2(siluf(g1.z) * u1.z, siluf(g1.w) * u1.w);
      *(uint4*)(act + (size_t)(m0 + row) * FP + nt * 64 + j8) = o;
    }
  } else if constexpr (EPI == EPI_IN_EVEN) {
    bf16_t* P = (bf16_t*)(p.ws + OFF_P);
    const float* rt = (const float*)(p.ws + OFF_ROPE);
    const bool latent = (m0 >= NP);
    if (nt == 48) {
      float* low = (float*)(p.ws + OFF_LOW);
#pragma unroll 4
      for (int ps = 0; ps < 4; ++ps) {
        const int row = ps * 32 + (tid >> 3), c4 = (tid & 7) * 4;
        *(float4*)(low + (size_t)(m0 + row) * 32 + c4) = *(const float4*)&Cs[row * CS_LD + c4];
      }
    } else {
#pragma unroll 4
      for (int ps = 0; ps < 8; ++ps) {
        const int row = ps * 16 + (tid >> 4), c8 = (tid & 15) * 8;
        const int m = m0 + row, n = n0 + c8;
        float4 v0 = *(const float4*)&Cs[row * CS_LD + c8];
        float4 v1 = *(const float4*)&Cs[row * CS_LD + c8 + 4];
        if (nt >= 8 && nt < 24 && !latent) {
          float* o = p.out + (nt < 16 ? OUT_AK : OUT_AV) + (size_t)m * 1024 + (n - (nt < 16 ? 1024 : 2048));
          *(float4*)o = v0; *(float4*)(o + 4) = v1;
        }
        if (nt < 16 && latent) {
          const int t = (m - NP) & 2047;
          const int d = c8 & 63, j = d & 31;
          const int pos = (d < 32) ? (t >> 6) : (t & 63);
          const float4 pv0 = *(const float4*)&Cs[row * CS_LD + (c8 ^ 16)];
          const float4 pv1 = *(const float4*)&Cs[row * CS_LD + (c8 ^ 16) + 4];
          const float sgn = (j < 16) ? -1.f : 1.f;
          rope4(v0, pv0, rt, rt + 1024, pos, 16, j & 15, sgn);
          rope4(v1, pv1, rt, rt + 1024, pos, 16, (j & 15) + 4, sgn);
        }
        if (!(nt >= 16 && nt < 24) && !(nt >= 32 && nt < 40)) {
          uint4 o; o.x = pack2(v0.x, v0.y); o.y = pack2(v0.z, v0.w); o.z = pack2(v1.x, v1.y); o.w = pack2(v1.z, v1.w);
          *(uint4*)(P + (size_t)m * EINP + n) = o;
        }
      }
      if ((nt >= 16 && nt < 24) || (nt >= 32 && nt < 40)) {
        const int head = (nt < 24) ? nt - 16 : nt - 32;
        bf16_t* base; int L, tok0;
        if (!latent) { const int b = m0 >> 8; tok0 = m0 & 255; L = PSEQ;
          base = (bf16_t*)(p.ws + (nt < 24 ? OFF_VTP : OFF_BVTP)) + (size_t)(b * 8 + head) * 128 * PSEQ; }
        else { const int b = (m0 - NP) >> 11; tok0 = (m0 - NP) & 2047; L = LP;
          base = (bf16_t*)(p.ws + (nt < 24 ? OFF_VTL : OFF_BVTL)) + (size_t)(b * 8 + head) * 128 * LP; }
#pragma unroll 2
        for (int i = 0; i < 8; ++i) {
          const int c = tid + 256 * i, dv = c & 127, tg = c >> 7;
          uint4 u;
          u.x = pack2(Cs[(tg * 8 + 0) * CS_LD + dv], Cs[(tg * 8 + 1) * CS_LD + dv]);
          u.y = pack2(Cs[(tg * 8 + 2) * CS_LD + dv], Cs[(tg * 8 + 3) * CS_LD + dv]);
          u.z = pack2(Cs[(tg * 8 + 4) * CS_LD + dv], Cs[(tg * 8 + 5) * CS_LD + dv]);
          u.w = pack2(Cs[(tg * 8 + 6) * CS_LD + dv], Cs[(tg * 8 + 7) * CS_LD + dv]);
          *(uint4*)(base + (size_t)dv * L + tok0 + tg * 8) = u;
        }
      }
    }
  } else {
    bf16_t* P = (bf16_t*)(p.ws + OFF_P);
    const float* rt = (const float*)(p.ws + OFF_ROPE) + 2048;
    const bool latent = (m0 >= NP);
#pragma unroll 4
    for (int ps = 0; ps < 8; ++ps) {
      const int row = ps * 16 + (tid >> 4), c8 = (tid & 15) * 8;
      const int m = m0 + row, n = n0 + c8;
      float4 v0 = *(const float4*)&Cs[row * CS_LD + c8];
      float4 v1 = *(const float4*)&Cs[row * CS_LD + c8 + 4];
      if (nt >= 16 && !latent) {
        float* o = p.out + (nt < 20 ? OUT_CK : OUT_CV) + (size_t)m * 512 + (n - (nt < 20 ? 2048 : 2560));
        *(float4*)o = v0; *(float4*)(o + 4) = v1;
      }
      if (nt < 20 && latent) {
        const int t = (m - NP) & 2047;
        const int d = c8, j = d & 63;
        const int pos = (d < 64) ? (t >> 6) : (t & 63);
        const float4 pv0 = *(const float4*)&Cs[row * CS_LD + (c8 ^ 32)];
        const float4 pv1 = *(const float4*)&Cs[row * CS_LD + (c8 ^ 32) + 4];
        const float sgn = (j < 32) ? -1.f : 1.f;
        rope4(v0, pv0, rt, rt + 2048, pos, 32, j & 31, sgn);
        rope4(v1, pv1, rt, rt + 2048, pos, 32, (j & 31) + 4, sgn);
      }
      if (nt < 20) {
        uint4 o; o.x = pack2(v0.x, v0.y); o.y = pack2(v0.z, v0.w); o.z = pack2(v1.x, v1.y); o.w = pack2(v1.z, v1.w);
        *(uint4*)(P + (size_t)m * OIN + n) = o;
      }
    }
    if (nt >= 20) {
      const int head = nt - 20;
      bf16_t* base; int L, tok0;
      if (!latent) { const int b = m0 >> 8; tok0 = m0 & 255; L = PSEQ; base = (bf16_t*)(p.ws + OFF_VTP) + (size_t)(b * 4 + head) * 128 * PSEQ; }
      else { const int b = (m0 - NP) >> 11; tok0 = (m0 - NP) & 2047; L = LP; base = (bf16_t*)(p.ws + OFF_VTL) + (size_t)(b * 4 + head) * 128 * LP; }
#pragma unroll 2
      for (int i = 0; i < 8; ++i) {
        const int c = tid + 256 * i, dv = c & 127, tg = c >> 7;
        uint4 u;
        u.x = pack2(Cs[(tg * 8 + 0) * CS_LD + dv], Cs[(tg * 8 + 1) * CS_LD + dv]);
        u.y = pack2(Cs[(tg * 8 + 2) * CS_LD + dv], Cs[(tg * 8 + 3) * CS_LD + dv]);
        u.z = pack2(Cs[(tg * 8 + 4) * CS_LD + dv], Cs[(tg * 8 + 5) * CS_LD + dv]);
        u.w = pack2(Cs[(tg * 8 + 6) * CS_LD + dv], Cs[(tg * 8 + 7) * CS_LD + dv]);
        *(uint4*)(base + (size_t)dv * L + tok0 + tg * 8) = u;
      }
    }
  }
}

template <int EPI>
DI void phase_gemm(const Params& p, const GemmArgs& ga, int Nt, int extra_nt, char* smem) {
  const int G = gridDim.x, bid = blockIdx.x;
  constexpr int Mt = NTOK / 128;
  if ((G & 63) == 0) {
    const int S = G >> 3, SM = S >> 3;
    const int xcd = bid & 7, slot = bid >> 3;
    const int nsm = Mt / SM, nsn = Nt >> 3;
    const int nsuper = nsm * nsn;
    const int lm = slot % SM, ln = slot / SM;
    for (int sid = xcd; sid < nsuper; sid += 8) {
      const int sm = sid % nsm, sn = sid / nsm;
      gemm_tile<EPI>(p, ga, sm * SM + lm, sn * 8 + ln, smem);
    }
  } else {
    for (int t = bid; t < Mt * Nt; t += G) gemm_tile<EPI>(p, ga, t % Mt, t / Mt, smem);
  }
  if (extra_nt >= 0) {
    for (int t = bid; t < Mt; t += G) gemm_tile<EPI>(p, ga, t, extra_nt, smem);
  }
}

template <int DQK, bool OUTBF>
DI void attn_item(const bf16_t* Q, int qstride,
                  const bf16_t* K0, int k0s, const bf16_t* Vt0, int vt0s, int n0,
                  const bf16_t* K1, int k1s, const bf16_t* Vt1, int vt1s, int s1, int e1,
                  float scl2, bool has_sink, float sink2, bool window, int qpos0,
                  void* Out, int ostride, char* smem) {
  constexpr int KST = DQK * 2 + 16;
  constexpr int KCH = DQK / 8;
  constexpr int KPT = DQK / 32;
  constexpr int NS = DQK / 16;
  const int tid = opaque_tid(), lane = tid & 63, w = tid >> 6, r = lane & 31, hh = lane >> 5;
  char* sK = smem; char* sV = smem + 64 * KST;
  constexpr bool QLDS = (DQK == 128);
  constexpr int NQF = QLDS ? 1 : NS;
  char* sQ = smem + 64 * KST + 128 * 144;
  bf16x8 qf[NQF];
  if constexpr (QLDS) {
    __syncthreads();
#pragma unroll
    for (int j = 0; j < 8; ++j) { int c = tid + 256 * j; int row = c >> 4, kc = c & 15;
      *(u32x4*)(sQ + row * KST + kc * 16) = *(const u32x4*)(Q + (size_t)row * qstride + kc * 8); }
  } else {
#pragma unroll
    for (int s = 0; s < NS; ++s) qf[s] = *(const bf16x8*)(Q + (size_t)(w * 32 + r) * qstride + s * 16 + hh * 8);
  }
  f32x16 OT[4];
#pragma unroll
  for (int t = 0; t < 4; ++t)
#pragma unroll
    for (int i = 0; i < 16; ++i) OT[t][i] = 0.f;
  float mrun = has_sink ? sink2 : -1e30f;
  float lrun = (has_sink && hh == 0) ? 1.f : 0.f;
  const int nt0 = n0 >> 6, NT = nt0 + ((e1 - s1) >> 6);
  u32x4 rk[KPT], rv[4];
  auto prefetch = [&](int T) {
    const bf16_t* Kp; const bf16_t* Vp; int ks, vs, key0;
    if (T < nt0) { Kp = K0; Vp = Vt0; ks = k0s; vs = vt0s; key0 = T * 64; }
    else { Kp = K1; Vp = Vt1; ks = k1s; vs = vt1s; key0 = s1 + (T - nt0) * 64; }
#pragma unroll
    for (int j = 0; j < KPT; ++j) { int c = tid + 256 * j; int row = c / KCH, kc = c % KCH; rk[j] = *(const u32x4*)(Kp + (size_t)(key0 + row) * ks + kc * 8); }
#pragma unroll
    for (int j = 0; j < 4; ++j) { int c = tid + 256 * j; int dv = c >> 3, kc = c & 7; rv[j] = *(const u32x4*)(Vp + (size_t)dv * vs + key0 + kc * 8); }
  };
  prefetch(0);
  for (int T = 0; T < NT; ++T) {
    __syncthreads();
#pragma unroll
    for (int j = 0; j < KPT; ++j) { int c = tid + 256 * j; int row = c / KCH, kc = c % KCH; *(u32x4*)(sK + row * KST + kc * 16) = rk[j]; }
#pragma unroll
    for (int j = 0; j < 4; ++j) { int c = tid + 256 * j; int dv = c >> 3, kc = c & 7; *(u32x4*)(sV + dv * 144 + kc * 16) = rv[j]; }
    __syncthreads();
    if (T + 1 < NT) prefetch(T + 1);
    f32x16 ST[2];
#pragma unroll
    for (int k2 = 0; k2 < 2; ++k2) {
#pragma unroll
      for (int i = 0; i < 16; ++i) ST[k2][i] = 0.f;
#pragma unroll
      for (int s = 0; s < NS; ++s) {
        bf16x8 kf = ld_frag16(sK + (k2 * 32 + r) * KST + (s * 16 + hh * 8) * 2);
        bf16x8 qv;
        if constexpr (QLDS) qv = ld_frag16(sQ + (w * 32 + r) * KST + (s * 16 + hh * 8) * 2); else qv = qf[s];
        ST[k2] = MFMA32(kf, qv, ST[k2]);
      }
      __builtin_amdgcn_sched_barrier(0);
    }
    const bool domask = window && (T >= nt0);
    const int key0w = s1 + (T - nt0) * 64;
    const int qpos = qpos0 + w * 32 + r;
    float tmax = -1e30f;
#pragma unroll
    for (int k2 = 0; k2 < 2; ++k2)
#pragma unroll
      for (int i = 0; i < 16; ++i) {
        float v = ST[k2][i];
        if (domask) { int kpos = key0w + k2 * 32 + crow(i, hh); int dd = qpos - kpos; if (dd > 128 || dd < -128) v = -1e30f; }
        ST[k2][i] = v; tmax = fmaxf(tmax, v);
      }
    tmax = fmaxf(tmax, __shfl_xor(tmax, 32, 64));
    const float mnew = fmaxf(mrun, tmax * scl2);
    const float alpha = __builtin_amdgcn_exp2f(mrun - mnew);
    mrun = mnew;
    float ls = 0.f;
#pragma unroll
    for (int k2 = 0; k2 < 2; ++k2)
#pragma unroll
      for (int i = 0; i < 16; ++i) { float pv = __builtin_amdgcn_exp2f(fmaf(ST[k2][i], scl2, -mnew)); ST[k2][i] = pv; ls += pv; }
    lrun = lrun * alpha + ls;
    __builtin_amdgcn_sched_barrier(0);
    if (__any(alpha != 1.f)) {
#pragma unroll
      for (int t = 0; t < 4; ++t)
#pragma unroll
        for (int i = 0; i < 16; ++i) OT[t][i] *= alpha;
    }
#pragma unroll
    for (int k2 = 0; k2 < 2; ++k2)
#pragma unroll
      for (int s = 0; s < 2; ++s) {
        bf16x8 pf = pack8(ST[k2], s);
#pragma unroll
        for (int t = 0; t < 4; ++t) {
          bf16x8 vf = ld_frag8x2(sV + (t * 32 + r) * 144 + (k2 * 32 + 16 * s + 4 * hh) * 2);
          OT[t] = MFMA32(vf, pf, OT[t]);
        }
        __builtin_amdgcn_sched_barrier(0);
      }
  }
  float ltot = lrun + __shfl_xor(lrun, 32, 64);
  const float inv = 1.f / ltot;
  const int q = w * 32 + r;
#pragma unroll
  for (int t = 0; t < 4; ++t)
#pragma unroll
    for (int g4 = 0; g4 < 4; ++g4) {
      const int dv = t * 32 + 8 * g4 + 4 * hh;
      float a = OT[t][4 * g4 + 0] * inv, b = OT[t][4 * g4 + 1] * inv, c = OT[t][4 * g4 + 2] * inv, d = OT[t][4 * g4 + 3] * inv;
      if constexpr (OUTBF) { uint2 u; u.x = pack2(a, b); u.y = pack2(c, d); *(uint2*)((bf16_t*)Out + (size_t)q * ostride + dv) = u; }
      else { float4 o; o.x = a; o.y = b; o.z = c; o.w = d; *(float4*)((float*)Out + (size_t)q * ostride + dv) = o; }
    }
}

constexpr size_t GLA_ITEM_BYTES = 16384 + 8192 + 256;
constexpr int GLA_NITEMS = 1024 + 2048;
static_assert((size_t)GLA_NITEMS * GLA_ITEM_BYTES <= (size_t)NTOK * D * 4, "gla scratch");
DI int gla_item_index(int seq, int head, int dir, int c) {
  return (seq >= 32) ? ((((seq - 32) * 8 + head) * 2 + dir) * 32 + c) : (1024 + (((seq * 8 + head) * 2 + dir) * 4 + c));
}

DI void gla_prep_item(const Params& p, int seq, int head, int dir, int c, char* smem) {
  const int tid = opaque_tid(), lane = tid & 63, w = tid >> 6, r = lane & 31, hh = lane >> 5;
  const bool latent = seq >= 32;
  const int L = latent ? LSEQ : PSEQ;
  const int tokbase = latent ? NP + (seq - 32) * LSEQ : seq * PSEQ;
  const bf16_t* P = (const bf16_t*)(p.ws + OFF_P);
  const float* LOW = (const float*)(p.ws + OFF_LOW);
  const int vpitch = latent ? LP : PSEQ;
  const bf16_t* Vt = latent ? (const bf16_t*)(p.ws + OFF_BVTL) + (size_t)((seq - 32) * 8 + head) * 128 * LP
                            : (const bf16_t*)(p.ws + OFF_BVTP) + (size_t)(seq * 8 + head) * 128 * PSEQ;
  bf16_t* GO = (bf16_t*)(p.ws + OFF_GO) + (size_t)dir * NTOK * 1024;
  char* gscr = p.ws + OFF_X + (size_t)gla_item_index(seq, head, dir, c) * GLA_ITEM_BYTES;
  char* s_qin = smem;
  char* s_kin = smem + 9216;
  char* s_ket = smem + 18432;
  char* s_vt  = smem + 27648;
  float* s_low = (float*)(smem + 46080);
  float* s_seg = (float*)(smem + 50176);
  float* s_dec = (float*)(smem + 51200);
  const int dk = lane, seg = w;
  float* s_wv = (float*)(smem + 51456);
  float* s_b = (float*)(smem + 55552);
  bf16_t* s_q = (bf16_t*)(smem + 18432);
  const int lt0 = (dir == 0) ? c * 64 : L - 64 * (c + 1);
  const int tok0 = tokbase + lt0;
  __syncthreads();
  {
#pragma unroll
    for (int j = 0; j < 4; ++j) { int idx = tid + 256 * j; s_wv[idx] = p.w_gate2[(size_t)(dir * 16 + (idx >> 6)) * 512 + head * 64 + (idx & 63)]; }
    const int i = tid >> 2, r4 = (tid & 3) * 4;
    *(float4*)(s_low + i * 16 + r4) = *(const float4*)(LOW + (size_t)(tok0 + i) * 32 + dir * 16 + r4);
#pragma unroll
    for (int j = 0; j < 4; ++j) { int cc = tid + 256 * j; int dv = cc >> 3, kc = cc & 7;
      *(uint4*)(s_vt + dv * 144 + kc * 16) = *(const uint4*)(Vt + (size_t)dv * vpitch + lt0 + kc * 8); }
#pragma unroll
    for (int j = 0; j < 2; ++j) { int cc = tid + 256 * j; int row = cc >> 3, kc = cc & 7;
      *(uint4*)(s_qin + row * 144 + kc * 16) = *(const uint4*)(P + (size_t)(tok0 + row) * EINP + 3072 + head * 64 + kc * 8);
      *(uint4*)(s_kin + row * 144 + kc * 16) = *(const uint4*)(P + (size_t)(tok0 + row) * EINP + 3584 + head * 64 + kc * 8); }
  }
  const float bias = p.b_gate[dir * 512 + head * 64 + dk];
  __syncthreads();
  {
    float run = 0.f;
    float wv[16];
#pragma unroll
    for (int j = 0; j < 16; ++j) wv[j] = s_wv[j * 64 + dk];
#pragma unroll 4
    for (int tt = 0; tt < 16; ++tt) {
      const int t = (dir == 0) ? tt : 15 - tt;
      const float* lw = s_low + (seg * 16 + t) * 16;
      float lg = bias;
#pragma unroll
      for (int j = 0; j < 16; ++j) lg += lw[j] * wv[j];
      run += (fminf(lg, 0.f) - __logf(1.f + __expf(-fabsf(lg)))) * (1.f / 16.f);
      s_b[(seg * 16 + t) * 64 + dk] = run;
    }
    s_seg[seg * 64 + dk] = run;
  }
  __syncthreads();
  float pre = 0.f, btot = 0.f;
#pragma unroll
  for (int s = 0; s < 4; ++s) {
    float v = s_seg[s * 64 + dk];
    btot += v;
    if ((dir == 0 && s < seg) || (dir == 1 && s > seg)) pre += v;
  }
#pragma unroll 4
  for (int t = 0; t < 16; ++t) {
    const int i = seg * 16 + t;
    const float b = pre + s_b[i * 64 + dk];
    const float qv = bf2f(*(const unsigned short*)(s_qin + i * 144 + dk * 2));
    const float kv = bf2f(*(const unsigned short*)(s_kin + i * 144 + dk * 2));
    *(unsigned short*)(s_qin + i * 144 + dk * 2) = f2bf(qv * 0.125f * __expf(b));
    *(unsigned short*)(s_kin + i * 144 + dk * 2) = f2bf(kv * __expf(-b));
    *(unsigned short*)(s_ket + dk * 144 + i * 2) = f2bf(kv * __expf(btot - b));
  }
  if (seg == 0) { const float dcy = __expf(btot); s_dec[dk] = dcy; ((float*)(gscr + 24576))[dk] = dcy; }
  __syncthreads();
#pragma unroll
  for (int j = 0; j < 2; ++j) { int cc = tid + 256 * j; int row = cc >> 3, kc = cc & 7;
    *(uint4*)(gscr + 16384 + row * 128 + kc * 16) = *(const uint4*)(s_qin + row * 144 + kc * 16); }
  f32x16 OT[2];
#pragma unroll
  for (int b = 0; b < 2; ++b)
#pragma unroll
    for (int i = 0; i < 16; ++i) OT[b][i] = 0.f;
#pragma unroll
  for (int a = 0; a < 2; ++a) {
    f32x16 AT[2];
#pragma unroll
    for (int b = 0; b < 2; ++b)
#pragma unroll
      for (int i = 0; i < 16; ++i) AT[b][i] = 0.f;
#pragma unroll
    for (int s = 0; s < 4; ++s) {
      bf16x8 kf = ld_frag16(s_kin + (a * 32 + r) * 144 + (s * 16 + hh * 8) * 2);
#pragma unroll
      for (int b = 0; b < 2; ++b) {
        bf16x8 qf = ld_frag16(s_qin + (b * 32 + r) * 144 + (s * 16 + hh * 8) * 2);
        AT[b] = MFMA32(kf, qf, AT[b]);
      }
    }
#pragma unroll
    for (int b = 0; b < 2; ++b)
#pragma unroll
      for (int i = 0; i < 16; ++i) {
        const int j = a * 32 + crow(i, hh), ii = b * 32 + r;
        const bool keep = (dir == 0) ? (j <= ii) : (j >= ii);
        if (!keep) AT[b][i] = 0.f;
      }
#pragma unroll
    for (int s2 = 0; s2 < 2; ++s2) {
      bf16x8 vf = ld_frag8x2(s_vt + (w * 32 + r) * 144 + (a * 32 + 16 * s2 + 4 * hh) * 2);
#pragma unroll
      for (int b = 0; b < 2; ++b) OT[b] = MFMA32(vf, pack8(AT[b], s2), OT[b]);
    }
  }
#pragma unroll
  for (int b = 0; b < 2; ++b)
#pragma unroll
    for (int g4 = 0; g4 < 4; ++g4) {
      uint2 o; o.x = pack2(OT[b][4 * g4], OT[b][4 * g4 + 1]); o.y = pack2(OT[b][4 * g4 + 2], OT[b][4 * g4 + 3]);
      *(uint2*)(GO + (size_t)(tok0 + b * 32 + r) * 1024 + head * 128 + w * 32 + 8 * g4 + 4 * hh) = o;
    }
#pragma unroll
  for (int T = 0; T < 2; ++T) {
    f32x16 KV;
#pragma unroll
    for (int i = 0; i < 16; ++i) KV[i] = 0.f;
#pragma unroll
    for (int s = 0; s < 4; ++s) {
      bf16x8 af = ld_frag16(s_ket + (T * 32 + r) * 144 + (s * 16 + hh * 8) * 2);
      bf16x8 bv = ld_frag16(s_vt + (w * 32 + r) * 144 + (s * 16 + hh * 8) * 2);
      KV = MFMA32(af, bv, KV);
    }
    *(bf16x8*)(gscr + ((T * 4 + w) * 64 + lane) * 32) = pack8(KV, 0);
    *(bf16x8*)(gscr + ((T * 4 + w) * 64 + lane) * 32 + 16) = pack8(KV, 1);
  }
}

DI void gla_chain_wave(const Params& p, int chain, int wt) {
  const int lane = threadIdx.x & 63, r = lane & 31, hh = lane >> 5;
  const bool latent = chain < 32;
  int seq, head, dir;
  if (latent) { dir = chain & 1; head = (chain >> 1) & 7; seq = 32 + (chain >> 4); }
  else { const int cc = chain - 32; dir = cc & 1; head = (cc >> 1) & 7; seq = cc >> 4; }
  const int nchunks = latent ? 32 : 4;
  char* gbase = p.ws + OFF_X + (size_t)gla_item_index(seq, head, dir, 0) * GLA_ITEM_BYTES;
  f32x16 S[2];
#pragma unroll
  for (int T = 0; T < 2; ++T)
#pragma unroll
    for (int i = 0; i < 16; ++i) {
      float v = 0.f;
      if (latent) v = p.state_b[((size_t)(((seq - 32) * 2 + dir) * 8 + head) * 64 + T * 32 + crow(i, hh)) * 128 + wt * 32 + r];
      S[T][i] = v;
    }
  bf16x8 kvf[2][2]; float4 dc[2][4];
#define CH_LOAD(G) { _Pragma("unroll") for (int T = 0; T < 2; ++T) { \
      kvf[T][0] = *(const bf16x8*)((G) + ((T * 4 + wt) * 64 + lane) * 32); \
      kvf[T][1] = *(const bf16x8*)((G) + ((T * 4 + wt) * 64 + lane) * 32 + 16); \
      _Pragma("unroll") for (int g4 = 0; g4 < 4; ++g4) dc[T][g4] = *(const float4*)((G) + 24576 + (T * 32 + 8 * g4 + 4 * hh) * 4); } }
  CH_LOAD(gbase);
  for (int c = 0; c < nchunks; ++c) {
    char* g = gbase + (size_t)c * GLA_ITEM_BYTES;
    bf16x8 kc[2][2]; float4 dcc[2][4];
#pragma unroll
    for (int T = 0; T < 2; ++T) { kc[T][0] = kvf[T][0]; kc[T][1] = kvf[T][1];
#pragma unroll
      for (int g4 = 0; g4 < 4; ++g4) dcc[T][g4] = dc[T][g4]; }
    if (c + 1 < nchunks) CH_LOAD(g + GLA_ITEM_BYTES);
#pragma unroll
    for (int T = 0; T < 2; ++T) {
      *(bf16x8*)(g + ((T * 4 + wt) * 64 + lane) * 32) = pack8(S[T], 0);
      *(bf16x8*)(g + ((T * 4 + wt) * 64 + lane) * 32 + 16) = pack8(S[T], 1);
#pragma unroll
      for (int g4 = 0; g4 < 4; ++g4) {
        S[T][4 * g4]     = S[T][4 * g4]     * dcc[T][g4].x + bf2f((unsigned short)kc[T][g4 >> 1][(g4 & 1) * 4 + 0]);
        S[T][4 * g4 + 1] = S[T][4 * g4 + 1] * dcc[T][g4].y + bf2f((unsigned short)kc[T][g4 >> 1][(g4 & 1) * 4 + 1]);
        S[T][4 * g4 + 2] = S[T][4 * g4 + 2] * dcc[T][g4].z + bf2f((unsigned short)kc[T][g4 >> 1][(g4 & 1) * 4 + 2]);
        S[T][4 * g4 + 3] = S[T][4 * g4 + 3] * dcc[T][g4].w + bf2f((unsigned short)kc[T][g4 >> 1][(g4 & 1) * 4 + 3]);
      }
    }
  }
#undef CH_LOAD
  if (!latent) {
    float* o = p.out + OUT_SB + (size_t)((seq * 2 + dir) * 8 + head) * 64 * 128;
#pragma unroll
    for (int T = 0; T < 2; ++T)
#pragma unroll
      for (int i = 0; i < 16; ++i) o[(size_t)(T * 32 + crow(i, hh)) * 128 + wt * 32 + r] = S[T][i];
  }
}

DI void phase_gla_chain(const Params& p) {
  const int w = threadIdx.x >> 6;
  const int nw = gridDim.x * 4;
  for (int id = blockIdx.x * 4 + w; id < 544 * 4; id += nw) gla_chain_wave(p, id >> 2, id & 3);
}

DI void gla_inter_wave(const Params& p, int item, int wt) {
  const int lane = threadIdx.x & 63, r = lane & 31, hh = lane >> 5;
  int seq, head, dir, c;
  if (item < 1024) { c = item & 31; const int ch = item >> 5; dir = ch & 1; head = (ch >> 1) & 7; seq = 32 + (ch >> 4); }
  else { const int jj = item - 1024; c = jj & 3; const int ch = jj >> 2; dir = ch & 1; head = (ch >> 1) & 7; seq = ch >> 4; }
  const bool latent = seq >= 32;
  const int L = latent ? LSEQ : PSEQ;
  const int tokbase = latent ? NP + (seq - 32) * LSEQ : seq * PSEQ;
  const int lt0 = (dir == 0) ? c * 64 : L - 64 * (c + 1);
  const int tok0 = tokbase + lt0;
  bf16_t* GO = (bf16_t*)(p.ws + OFF_GO) + (size_t)dir * NTOK * 1024;
  const char* g = p.ws + OFF_X + (size_t)item * GLA_ITEM_BYTES;
  f32x16 OT[2];
#pragma unroll
  for (int b = 0; b < 2; ++b)
#pragma unroll
    for (int g4 = 0; g4 < 4; ++g4) {
      const uint2 o = *(const uint2*)(GO + (size_t)(tok0 + b * 32 + r) * 1024 + head * 128 + wt * 32 + 8 * g4 + 4 * hh);
      OT[b][4 * g4] = bf2f(o.x & 0xffff); OT[b][4 * g4 + 1] = bf2f(o.x >> 16); OT[b][4 * g4 + 2] = bf2f(o.y & 0xffff); OT[b][4 * g4 + 3] = bf2f(o.y >> 16);
    }
#pragma unroll
  for (int T = 0; T < 2; ++T)
#pragma unroll
    for (int s2 = 0; s2 < 2; ++s2) {
      bf16x8 sf = *(const bf16x8*)(g + ((T * 4 + wt) * 64 + lane) * 32 + s2 * 16);
#pragma unroll
      for (int b = 0; b < 2; ++b) {
        const char* qp = g + 16384 + (b * 32 + r) * 128 + (T * 32 + 16 * s2 + 4 * hh) * 2;
        s16x4 lo = *(const s16x4*)qp; s16x4 hi = *(const s16x4*)(qp + 16);
        bf16x8 qf = __builtin_shufflevector(lo, hi, 0, 1, 2, 3, 4, 5, 6, 7);
        OT[b] = MFMA32(sf, qf, OT[b]);
      }
    }
#pragma unroll
  for (int b = 0; b < 2; ++b)
#pragma unroll
    for (int g4 = 0; g4 < 4; ++g4) {
      uint2 o; o.x = pack2(OT[b][4 * g4], OT[b][4 * g4 + 1]); o.y = pack2(OT[b][4 * g4 + 2], OT[b][4 * g4 + 3]);
      *(uint2*)(GO + (size_t)(tok0 + b * 32 + r) * 1024 + head * 128 + wt * 32 + 8 * g4 + 4 * hh) = o;
    }
}

DI void phase_gla_inter(const Params& p) {
  const int w = threadIdx.x >> 6;
  const int nw = gridDim.x * 4;
  for (int id = blockIdx.x * 4 + w; id < GLA_NITEMS * 4; id += nw) gla_inter_wave(p, id >> 2, id & 3);
}

DI int next_item(int* counter, int* s_item) {
  __syncthreads();
  if (threadIdx.x == 0) *s_item = atomicAdd(counter, 1);
  __syncthreads();
  return __builtin_amdgcn_readfirstlane(*s_item);
}

constexpr float LOG2E = 1.4426950408889634f;

DI void phase_mixer_even(const Params& p, char* smem, int* s_item) {
  int* counter = (int*)(p.ws + OFF_CNT) + 0;
  const bf16_t* P = (const bf16_t*)(p.ws + OFF_P);
  bf16_t* OD = (bf16_t*)(p.ws + OFF_OD);
  const float scl2 = 0.125f * LOG2E;
  for (;;) {
    const int id = next_item(counter, s_item);
    if (id >= 512 + 1024 + GLA_NITEMS) break;
    if (id < 512) {
      const int j = id; const int qb = j & 15, map = (j >> 4) & 1, head = (j >> 5) & 7, b = j >> 8;
      const int m0 = NP + b * LSEQ + qb * 128;
      attn_item<64, true>(P + (size_t)m0 * EINP + head * 128 + map * 64, EINP,
                           (const bf16_t*)(p.ws + OFF_KCA) + (size_t)b * 512 * 1024 + head * 128 + map * 64, 1024,
                           (const bf16_t*)(p.ws + OFF_VTCA) + (size_t)(b * 8 + head) * 128 * 512, 512, 512,
                           P + (size_t)(NP + b * LSEQ) * EINP + 1024 + head * 128 + map * 64, EINP,
                           (const bf16_t*)(p.ws + OFF_VTL) + (size_t)(b * 8 + head) * 128 * LP, LP, 0, LSEQ,
                           scl2, false, 0.f, false, 0,
                           OD + ((size_t)m0 * 2 + map) * 1024 + head * 128, 2048, smem);
    } else if (id < 512 + GLA_NITEMS) {
      const int j = id - 512;
      if (j < 1024) { const int c = j & 31, ch = j >> 5; gla_prep_item(p, 32 + (ch >> 4), (ch >> 1) & 7, ch & 1, c, smem); }
      else { const int jj = j - 1024; const int c = jj & 3, ch = jj >> 2; gla_prep_item(p, ch >> 4, (ch >> 1) & 7, ch & 1, c, smem); }
    } else {
      const int j = id - 512 - GLA_NITEMS; const int qb = j & 1, map = (j >> 1) & 1, head = (j >> 2) & 7, b = j >> 5;
      const int m0 = b * PSEQ + qb * 128;
      attn_item<64, true>(P + (size_t)m0 * EINP + head * 128 + map * 64, EINP,
                           nullptr, 0, nullptr, 0, 0,
                           P + (size_t)(b * PSEQ) * EINP + 1024 + head * 128 + map * 64, EINP,
                           (const bf16_t*)(p.ws + OFF_VTP) + (size_t)(b * 8 + head) * 128 * PSEQ, PSEQ, 0, PSEQ,
                           scl2, false, 0.f, false, 0,
                           OD + ((size_t)m0 * 2 + map) * 1024 + head * 128, 2048, smem);
    }
  }
}

DI void phase_yprep_even(const Params& p) {
  const int lane = threadIdx.x & 63, w = threadIdx.x >> 6, hq = lane >> 4, l16 = lane & 15;
  const float lam = ((const float*)(p.ws + OFF_MISC))[0];
  const bf16_t* OD = (const bf16_t*)(p.ws + OFF_OD);
  const bf16_t* GO = (const bf16_t*)(p.ws + OFF_GO);
  const bf16_t* P = (const bf16_t*)(p.ws + OFF_P);
  bf16_t* Y = (bf16_t*)(p.ws + OFF_H);
  float sg[8], gg[8];
#pragma unroll
  for (int j = 0; j < 8; ++j) { sg[j] = p.subln_g[l16 * 8 + j]; gg[j] = p.gla_norm_g[l16 * 8 + j]; }
#define UNPK8(U, F) { F[0] = bf2f(U.x & 0xffff); F[1] = bf2f(U.x >> 16); F[2] = bf2f(U.y & 0xffff); F[3] = bf2f(U.y >> 16); \
                      F[4] = bf2f(U.z & 0xffff); F[5] = bf2f(U.z >> 16); F[6] = bf2f(U.w & 0xffff); F[7] = bf2f(U.w >> 16); }
  for (int tok = blockIdx.x * 4 + w; tok < NTOK; tok += gridDim.x * 4) {
#pragma unroll
    for (int hp = 0; hp < 2; ++hp) {
      const int head = hp * 4 + hq;
      const uint4 ua = *(const uint4*)(OD + ((size_t)tok * 2 + 0) * 1024 + head * 128 + l16 * 8);
      const uint4 ub = *(const uint4*)(OD + ((size_t)tok * 2 + 1) * 1024 + head * 128 + l16 * 8);
      float a[8], b[8], o[8];
      UNPK8(ua, a); UNPK8(ub, b);
      float ss = 0.f;
#pragma unroll
      for (int j = 0; j < 8; ++j) { o[j] = a[j] - lam * b[j]; ss += o[j] * o[j]; }
#pragma unroll
      for (int off = 8; off >= 1; off >>= 1) ss += __shfl_xor(ss, off, 64);
      const float rs = rsqrtf(ss * (1.f / 128.f) + 1e-6f) * 0.8f;
      uint4 u;
      u.x = pack2(o[0] * rs * sg[0], o[1] * rs * sg[1]); u.y = pack2(o[2] * rs * sg[2], o[3] * rs * sg[3]);
      u.z = pack2(o[4] * rs * sg[4], o[5] * rs * sg[5]); u.w = pack2(o[6] * rs * sg[6], o[7] * rs * sg[7]);
      *(uint4*)(Y + (size_t)tok * DP + head * 128 + l16 * 8) = u;
    }
#pragma unroll
    for (int hp = 0; hp < 2; ++hp) {
      const int head = hp * 4 + hq;
      const uint4 ua = *(const uint4*)(GO + (size_t)tok * 1024 + head * 128 + l16 * 8);
      const uint4 ub = *(const uint4*)(GO + (size_t)NTOK * 1024 + (size_t)tok * 1024 + head * 128 + l16 * 8);
      const uint4 ur = *(const uint4*)(P + (size_t)tok * EINP + 5120 + head * 128 + l16 * 8);
      float a[8], b[8], br[8], o[8];
      UNPK8(ua, a); UNPK8(ub, b); UNPK8(ur, br);
      float ss = 0.f;
#pragma unroll
      for (int j = 0; j < 8; ++j) { o[j] = a[j] + b[j]; ss += o[j] * o[j]; }
#pragma unroll
      for (int off = 8; off >= 1; off >>= 1) ss += __shfl_xor(ss, off, 64);
      const float rs = rsqrtf(ss * (1.f / 128.f) + 1e-6f);
      uint4 u;
      u.x = pack2(o[0] * rs * gg[0] * siluf(br[0]), o[1] * rs * gg[1] * siluf(br[1]));
      u.y = pack2(o[2] * rs * gg[2] * siluf(br[2]), o[3] * rs * gg[3] * siluf(br[3]));
      u.z = pack2(o[4] * rs * gg[4] * siluf(br[4]), o[5] * rs * gg[5] * siluf(br[5]));
      u.w = pack2(o[6] * rs * gg[6] * siluf(br[6]), o[7] * rs * gg[7] * siluf(br[7]));
      *(uint4*)(Y + (size_t)tok * DP + 1024 + head * 128 + l16 * 8) = u;
    }
  }
#undef UNPK8
}

DI void phase_attn_odd(const Params& p, char* smem, int* s_item) {
  int* counter = (int*)(p.ws + OFF_CNT) + 1;
  const bf16_t* P = (const bf16_t*)(p.ws + OFF_P);
  bf16_t* Y = (bf16_t*)(p.ws + OFF_H);
  const float scl2 = 0.08838834764831845f * LOG2E;
  for (;;) {
    const int id = next_item(counter, s_item);
    if (id >= 1536) break;
    if (id < 512) {
      const int qb = id & 15, head = (id >> 4) & 15, b = id >> 8;
      const int kvh = head >> 2;
      const int m0 = NP + b * LSEQ + qb * 128;
      const int s1 = (qb == 0) ? 0 : (qb - 1) * 128;
      const int e1 = (qb + 2 > 16) ? LSEQ : (qb + 2) * 128;
      attn_item<128, true>(P + (size_t)m0 * OIN + head * 128, OIN,
                           (const bf16_t*)(p.ws + OFF_KCC) + (size_t)b * 512 * 512 + kvh * 128, 512,
                           (const bf16_t*)(p.ws + OFF_VTCC) + (size_t)(b * 4 + kvh) * 128 * 512, 512, 512,
                           P + (size_t)(NP + b * LSEQ) * OIN + 2048 + kvh * 128, OIN,
                           (const bf16_t*)(p.ws + OFF_VTL) + (size_t)(b * 4 + kvh) * 128 * LP, LP, s1, e1,
                           scl2, true, p.sinks[head] * LOG2E, true, qb * 128,
                           Y + (size_t)m0 * DP + head * 128, DP, smem);
    } else {
      const int j = id - 512; const int qb = j & 1, head = (j >> 1) & 15, b = j >> 5;
      const int kvh = head >> 2;
      const int m0 = b * PSEQ + qb * 128;
      attn_item<128, true>(P + (size_t)m0 * OIN + head * 128, OIN,
                           nullptr, 0, nullptr, 0, 0,
                           P + (size_t)(b * PSEQ) * OIN + 2048 + kvh * 128, OIN,
                           (const bf16_t*)(p.ws + OFF_VTP) + (size_t)(b * 4 + kvh) * 128 * PSEQ, PSEQ, 0, PSEQ,
                           scl2, true, p.sinks[head] * LOG2E, false, 0,
                           Y + (size_t)m0 * DP + head * 128, DP, smem);
    }
  }
}


#define XB_TMO      128
#define XB_XCNT(j)  (256  + 64 * (j))
#define XB_XSUB(j)  (1280 + 64 * (j))
#define XB_XGEN(j)  (2304 + 64 * (j))
#define XB_TOP      3328
#define XB_TOPGEN   3392
#define XB_SPIN_CAP (1u << 22)
DI unsigned xb_ld(unsigned* p)              { return __hip_atomic_load(p, __ATOMIC_RELAXED, __HIP_MEMORY_SCOPE_AGENT); }
DI unsigned xb_add(unsigned* p, unsigned v) { return __hip_atomic_fetch_add(p, v, __ATOMIC_RELAXED, __HIP_MEMORY_SCOPE_AGENT); }
DI unsigned xb_xcc_id() { return (unsigned)__builtin_amdgcn_s_getreg((3 << 11) | 20) & 0xFu; }
#define XB_SPIN(cond, bar) do { unsigned _sp = 0; while (cond) { __builtin_amdgcn_s_sleep(1); \
    if ((++_sp & 255u) == 0u) { if (xb_ld(&(bar)[XB_TMO])) break; if (_sp > XB_SPIN_CAP) { atomicAdd(&(bar)[XB_TMO], 1u); break; } } } } while (0)
struct XcdBarrier { unsigned* bar; unsigned x; volatile LAS unsigned* st; };
DI XcdBarrier xcd_barrier_post(unsigned* bar, volatile LAS unsigned* st) {
  XcdBarrier b; b.bar = bar; b.x = xb_xcc_id(); b.st = st;
  if (threadIdx.x == 0) (void)xb_add(&bar[XB_XCNT(b.x)], 1u);
  return b;
}
DI void xcd_barrier_complete(unsigned* bar, unsigned x, unsigned& nloc, unsigned& nx) {
  const unsigned G = gridDim.x * gridDim.y * gridDim.z;
  unsigned sum, cnt, mine, sp = 0u;
  for (;;) {
    sum = 0u; cnt = 0u; mine = 0u;
#pragma unroll
    for (unsigned j = 0; j < 16; ++j) { const unsigned c = xb_ld(&bar[XB_XCNT(j)]); sum += c; cnt += (c > 0u) ? 1u : 0u; mine = (j == x) ? c : mine; }
    if (sum == G) break;
    __builtin_amdgcn_s_sleep(1);
    if ((++sp & 255u) == 0u) { if (xb_ld(&bar[XB_TMO])) break; if (sp > XB_SPIN_CAP) { atomicAdd(&bar[XB_TMO], 1u); break; } }
  }
  nloc = mine > 0u ? mine : 1u; nx = cnt > 0u ? cnt : 1u;
}
DI void xcd_barrier(const XcdBarrier& b) {
  asm volatile("s_waitcnt vmcnt(0)" ::: "memory");
  __syncthreads();
  if (threadIdx.x == 0) {
    unsigned* bar = b.bar;
    __builtin_amdgcn_s_waitcnt(0);
    unsigned nloc = b.st[0], nx = b.st[1];
    if (nloc == 0u) { xcd_barrier_complete(bar, b.x, nloc, nx); b.st[0] = nloc; b.st[1] = nx; }
    const unsigned old = xb_add(&bar[XB_XSUB(b.x)], 1u);
    const unsigned gen = old / nloc;
    if (old + 1u == (gen + 1u) * nloc) {
      __builtin_amdgcn_fence(__ATOMIC_RELEASE, "agent");
      asm volatile("s_waitcnt vmcnt(0)" ::: "memory");
      const unsigned og = xb_add(&bar[XB_TOP], 1u);
      const unsigned tg = og / nx;
      if (og + 1u == (tg + 1u) * nx) xb_add(&bar[XB_TOPGEN], 1u);
      else XB_SPIN(xb_ld(&bar[XB_TOPGEN]) == tg, bar);
      __builtin_amdgcn_fence(__ATOMIC_ACQUIRE, "agent");
      xb_add(&bar[XB_XGEN(b.x)], 1u);
      asm volatile("s_waitcnt vmcnt(0)" ::: "memory");
    } else {
      XB_SPIN(xb_ld(&bar[XB_XGEN(b.x)]) == gen, bar);
      __builtin_amdgcn_fence(__ATOMIC_ACQUIRE, "agent");
      asm volatile("s_waitcnt vmcnt(0)" ::: "memory");
    }
  }
  __syncthreads();
}

__global__ void __launch_bounds__(256, 2) fwd_megakernel(Params p) {
  __shared__ __attribute__((aligned(1024))) char smem[SMEM_BYTES + 16];
  int* s_item = (int*)(smem + SMEM_BYTES);
  cg::grid_group grid = cg::this_grid();
  if (p.ph_lo < 0) grid.sync();
  if (threadIdx.x == 0) { ((unsigned*)(smem + SMEM_BYTES))[2] = 0u; ((unsigned*)(smem + SMEM_BYTES))[3] = 0u; }
  __syncthreads();
  XcdBarrier xb = xcd_barrier_post((unsigned*)(p.ws + OFF_BAR), (volatile LAS unsigned*)(smem + SMEM_BYTES + 8));
  const bf16_t* H = (const bf16_t*)(p.ws + OFF_H);
#define RUN_PHASE(ph, ...) if (p.ph_lo <= (ph) && (ph) < p.ph_hi) { if ((ph) > p.ph_lo) xcd_barrier(xb); __VA_ARGS__ }
  RUN_PHASE(0, phase_prep(p, smem);)
  RUN_PHASE(1, phase_norm(p, 0, 0, true, false);)
  RUN_PHASE(2, { GemmArgs ga{H, DP, (const bf16_t*)(p.ws + OFF_WIE), DP, D, 0, 0, false}; phase_gemm<EPI_IN_EVEN>(p, ga, 48, 48, smem); })
  RUN_PHASE(3, phase_mixer_even(p, smem, s_item);)
  RUN_PHASE(4, phase_gla_chain(p);)
  RUN_PHASE(5, phase_gla_inter(p);)
  RUN_PHASE(6, phase_yprep_even(p);)
  RUN_PHASE(7, { GemmArgs ga{H, DP, (const bf16_t*)(p.ws + OFF_WOE), DP, D, 0, 0, true}; phase_gemm<EPI_RESID>(p, ga, 16, -1, smem); })
  RUN_PHASE(8, phase_norm(p, 0, 1, false, false);)
  RUN_PHASE(9, { GemmArgs ga{H, DP, (const bf16_t*)(p.ws + OFF_WFI), DP, D, 0, 0, false}; phase_gemm<EPI_SWIGLU>(p, ga, 88, -1, smem); })
  RUN_PHASE(10, { GemmArgs ga{(const bf16_t*)(p.ws + OFF_ACT), FP, (const bf16_t*)(p.ws + OFF_WFO), FP, DFF, 0, 1, false}; phase_gemm<EPI_RESID>(p, ga, 16, -1, smem); })
  RUN_PHASE(11, phase_norm(p, 1, 0, false, false);)
  RUN_PHASE(12, { GemmArgs ga{H, DP, (const bf16_t*)(p.ws + OFF_WIO), DP, D, 1, 0, false}; phase_gemm<EPI_IN_ODD>(p, ga, 24, -1, smem); })
  RUN_PHASE(13, phase_attn_odd(p, smem, s_item);)
  RUN_PHASE(14, { GemmArgs ga{H, DP, (const bf16_t*)(p.ws + OFF_WOO), DP, D, 1, 0, false}; phase_gemm<EPI_RESID>(p, ga, 16, -1, smem); })
  RUN_PHASE(15, phase_norm(p, 1, 1, false, false);)
  RUN_PHASE(16, { GemmArgs ga{H, DP, (const bf16_t*)(p.ws + OFF_WFI) + (size_t)2 * DFF * DP, DP, D, 1, 0, false}; phase_gemm<EPI_SWIGLU>(p, ga, 88, -1, smem); })
  RUN_PHASE(17, { GemmArgs ga{(const bf16_t*)(p.ws + OFF_ACT), FP, (const bf16_t*)(p.ws + OFF_WFO) + (size_t)D * FP, FP, DFF, 1, 1, false}; phase_gemm<EPI_RESID>(p, ga, 16, -1, smem); })
  RUN_PHASE(18, phase_norm(p, 0, 0, false, true);)
}

extern "C" void kernel_launch(void* const* d_in, const int* in_sizes, int n_in, void* d_out, int out_size,
                              void* d_ws, size_t ws_size, hipStream_t stream) {
  if (ws_size < WS_TOTAL) { fprintf(stderr, "workspace too small: %zu < %zu\n", ws_size, (size_t)WS_TOTAL); return; }
  static int grid_blocks = 0;
  if (!grid_blocks) {
    int dev = 0, cus = 0, per_cu = 0;
    hipGetDevice(&dev);
    hipDeviceGetAttribute(&cus, hipDeviceAttributeMultiprocessorCount, dev);
    hipOccupancyMaxActiveBlocksPerMultiprocessor(&per_cu, fwd_megakernel, 256, 0);
    if (per_cu > 2) per_cu = 2;
    if (per_cu < 1) per_cu = 1;
    grid_blocks = cus * per_cu;
  }
  Params p{};
  p.x_prompt = (const float*)d_in[0]; p.x_sample = (const float*)d_in[1]; p.c = (const float*)d_in[2];
  p.cache_a_k = (const float*)d_in[3]; p.cache_a_v = (const float*)d_in[4]; p.state_b = (const float*)d_in[5];
  p.cache_c_k = (const float*)d_in[6]; p.cache_c_v = (const float*)d_in[7]; p.c_ctx = (const float*)d_in[8];
  p.w_ada = (const float*)d_in[9]; p.b_ada = (const float*)d_in[10]; p.norm_g = (const float*)d_in[11];
  p.w_in_even = (const float*)d_in[12]; p.lam_q1 = (const float*)d_in[13]; p.lam_k1 = (const float*)d_in[14];
  p.lam_q2 = (const float*)d_in[15]; p.lam_k2 = (const float*)d_in[16]; p.subln_g = (const float*)d_in[17];
  p.w_gate1 = (const float*)d_in[18]; p.w_gate2 = (const float*)d_in[19]; p.b_gate = (const float*)d_in[20];
  p.gla_norm_g = (const float*)d_in[21]; p.w_out_even = (const float*)d_in[22]; p.w_in_odd = (const float*)d_in[23];
  p.sinks = (const float*)d_in[24]; p.w_out_odd = (const float*)d_in[25]; p.w_ffn_in = (const float*)d_in[26];
  p.w_ffn_out = (const float*)d_in[27]; p.final_norm_g = (const float*)d_in[28];
  p.out = (float*)d_out; p.ws = (char*)d_ws;
  p.ph_lo = 0; p.ph_hi = 19;
  hipMemsetAsync(d_ws, 0, ZERO_BYTES, stream);
  void* args[] = {&p};
  hipError_t e = hipLaunchCooperativeKernel((void*)fwd_megakernel, dim3(grid_blocks), dim3(256), args, 0, stream);
  if (e != hipSuccess) fprintf(stderr, "cooperative launch failed: %s (grid %d)\n", hipGetErrorString(e), grid_blocks);
}
```

```cpp
#include <hip/hip_runtime.h>
#include <hip/hip_cooperative_groups.h>
#include <stdint.h>
#include <cstdio>
namespace cg = cooperative_groups;

typedef unsigned short bf16_t;
using bf16x8 = __attribute__((ext_vector_type(8))) short;
using s16x4  = __attribute__((ext_vector_type(4))) short;
using f32x16 = __attribute__((ext_vector_type(16))) float;
using u32x4  = __attribute__((ext_vector_type(4))) unsigned;
using f32x4  = __attribute__((ext_vector_type(4))) float;
#define MFMA16(a, b, c) __builtin_amdgcn_mfma_f32_16x16x32_bf16((a), (b), (c), 0, 0, 0)
#define DI __device__ __forceinline__
#define LAS __attribute__((address_space(3)))
#define MFMA32(a, b, c) __builtin_amdgcn_mfma_f32_32x32x16_bf16((a), (b), (c), 0, 0, 0)

constexpr int D = 2048;
constexpr int NP = 8192;
constexpr int NL = 4096;
constexpr int NTOK = NP + NL;
constexpr int LSEQ = 2048;
constexpr int PSEQ = 256;
constexpr int PAST = 512;
constexpr int DFF = 5632;
constexpr int EIN = 6144;
constexpr int EINP = 6272;
constexpr int OIN = 3072;
constexpr int MODW = 6 * D;
constexpr int DP = D + 64;
constexpr int FP = DFF + 64;
constexpr int LP = LSEQ + 64;

constexpr size_t al256(size_t x) { return (x + 255) & ~(size_t)255; }
constexpr size_t OFF_MOD   = 0;
constexpr size_t OFF_CNT   = OFF_MOD + (size_t)2 * 3 * MODW * 4;
constexpr size_t OFF_BAR   = OFF_CNT + 256;
constexpr size_t ZERO_BYTES = OFF_BAR + 3456 * 4;
constexpr size_t OFF_MISC  = ZERO_BYTES;
constexpr size_t OFF_ROPE  = OFF_MISC + 256;
constexpr size_t OFF_WIE   = al256(OFF_ROPE + (size_t)(64 * 16 * 2 + 64 * 32 * 2) * 4);
constexpr size_t OFF_WOE   = OFF_WIE + (size_t)EINP * DP * 2;
constexpr size_t OFF_WIO   = OFF_WOE + (size_t)D * DP * 2;
constexpr size_t OFF_WOO   = OFF_WIO + (size_t)OIN * DP * 2;
constexpr size_t OFF_WFI   = OFF_WOO + (size_t)D * DP * 2;
constexpr size_t OFF_WFO   = OFF_WFI + (size_t)2 * 2 * DFF * DP * 2;
constexpr size_t OFF_X     = OFF_WFO + (size_t)2 * D * FP * 2;
constexpr size_t OFF_H     = OFF_X + (size_t)NTOK * D * 4;
constexpr size_t OFF_P     = OFF_H + (size_t)NTOK * DP * 2;
constexpr size_t OFF_ACT   = OFF_P + (size_t)NTOK * EINP * 2;
constexpr size_t OFF_OD    = OFF_ACT;
constexpr size_t OFF_BVTP  = OFF_OD + (size_t)NTOK * 2 * 1024 * 4;
constexpr size_t OFF_BVTL  = OFF_BVTP + (size_t)256 * 128 * 256 * 2;
constexpr size_t OFF_GO    = OFF_ACT + (size_t)NTOK * FP * 2;
constexpr size_t OFF_VTP   = OFF_GO + (size_t)2 * NTOK * 1024 * 4;
constexpr size_t OFF_VTL   = OFF_VTP + (size_t)256 * 128 * 256 * 2;
constexpr size_t OFF_KCA   = OFF_VTL + (size_t)16 * 128 * LP * 2;
constexpr size_t OFF_VTCA  = OFF_KCA + (size_t)2 * 512 * 1024 * 2;
constexpr size_t OFF_KCC   = OFF_VTCA + (size_t)16 * 128 * 512 * 2;
constexpr size_t OFF_VTCC  = OFF_KCC + (size_t)2 * 512 * 512 * 2;
constexpr size_t OFF_LOW   = OFF_VTCC + (size_t)8 * 128 * 512 * 2;
constexpr size_t WS_TOTAL  = OFF_LOW + (size_t)NTOK * 32 * 4;
static_assert(OFF_BVTL + (size_t)16 * 128 * LP * 2 <= OFF_GO, "alias overflow");

constexpr size_t OUT_YP = 0;
constexpr size_t OUT_YS = OUT_YP + (size_t)NP * D;
constexpr size_t OUT_AK = OUT_YS + (size_t)NL * D;
constexpr size_t OUT_AV = OUT_AK + (size_t)NP * 1024;
constexpr size_t OUT_SB = OUT_AV + (size_t)NP * 1024;
constexpr size_t OUT_CK = OUT_SB + (size_t)32 * 2 * 8 * 64 * 128;
constexpr size_t OUT_CV = OUT_CK + (size_t)NP * 512;

struct Params {
  const float* x_prompt; const float* x_sample; const float* c;
  const float* cache_a_k; const float* cache_a_v; const float* state_b;
  const float* cache_c_k; const float* cache_c_v; const float* c_ctx;
  const float* w_ada; const float* b_ada; const float* norm_g;
  const float* w_in_even; const float* lam_q1; const float* lam_k1; const float* lam_q2; const float* lam_k2;
  const float* subln_g; const float* w_gate1; const float* w_gate2; const float* b_gate; const float* gla_norm_g;
  const float* w_out_even; const float* w_in_odd; const float* sinks; const float* w_out_odd;
  const float* w_ffn_in; const float* w_ffn_out; const float* final_norm_g;
  float* out; char* ws;
  int ph_lo; int ph_hi;
};

constexpr int SMEM_BYTES = 73728;

typedef float f32x2_t __attribute__((ext_vector_type(2)));
typedef __bf16 bf16x2_t __attribute__((ext_vector_type(2)));
DI unsigned pack2(float a, float b) { f32x2_t v = {a, b}; return __builtin_bit_cast(unsigned, __builtin_convertvector(v, bf16x2_t)); }
DI unsigned short f2bf(float x) { return (unsigned short)(pack2(x, 0.f) & 0xffffu); }
DI float bf2f(unsigned short v) { return __uint_as_float(((unsigned)v) << 16); }
DI int opaque_tid() { int t = threadIdx.x; asm volatile("" : "+v"(t)); return t; }
DI int crow(int reg, int h) { return (reg & 3) + 8 * (reg >> 2) + 4 * h; }
DI float wave_sum(float v) {
#pragma unroll
  for (int o = 32; o >= 1; o >>= 1) v += __shfl_xor(v, o, 64);
  return v;
}
DI float half_sum(float v) {
#pragma unroll
  for (int o = 16; o >= 1; o >>= 1) v += __shfl_xor(v, o, 64);
  return v;
}
DI float siluf(float x) { return x * __builtin_amdgcn_rcpf(1.f + __expf(-x)); }
DI int modrow(int m) { return m < NP ? 0 : 1 + ((m - NP) >> 11); }
DI bf16x8 pack8(const f32x16& x, int s) {
  uint4 u;
  u.x = pack2(x[8 * s + 0], x[8 * s + 1]); u.y = pack2(x[8 * s + 2], x[8 * s + 3]);
  u.z = pack2(x[8 * s + 4], x[8 * s + 5]); u.w = pack2(x[8 * s + 6], x[8 * s + 7]);
  return __builtin_bit_cast(bf16x8, u);
}
DI bf16x8 ld_frag16(const char* p) { return *(const bf16x8*)p; }
DI bf16x8 ld_frag8x2(const char* p) {
  s16x4 lo = *(const s16x4*)p; s16x4 hi = *(const s16x4*)(p + 16);
  return __builtin_shufflevector(lo, hi, 0, 1, 2, 3, 4, 5, 6, 7);
}

DI void wt_tile(const float* __restrict__ src, int K, int N, bf16_t* __restrict__ dst, int KP, int k0, int n0, int drow0, char* smem) {
  float* t = (float*)smem;
  const int tid = opaque_tid();
  __syncthreads();
#pragma unroll
  for (int i = 0; i < 4; ++i) {
    int k = (tid >> 4) + 16 * i, n4 = (tid & 15) * 4;
    float4 v = *(const float4*)(src + (size_t)(k0 + k) * N + n0 + n4);
    t[k * 65 + n4 + 0] = v.x; t[k * 65 + n4 + 1] = v.y; t[k * 65 + n4 + 2] = v.z; t[k * 65 + n4 + 3] = v.w;
  }
  __syncthreads();
#pragma unroll
  for (int i = 0; i < 2; ++i) {
    int c = tid + 256 * i, n = c >> 3, kg = c & 7;
    uint4 u;
    u.x = pack2(t[(kg * 8 + 0) * 65 + n], t[(kg * 8 + 1) * 65 + n]);
    u.y = pack2(t[(kg * 8 + 2) * 65 + n], t[(kg * 8 + 3) * 65 + n]);
    u.z = pack2(t[(kg * 8 + 4) * 65 + n], t[(kg * 8 + 5) * 65 + n]);
    u.w = pack2(t[(kg * 8 + 6) * 65 + n], t[(kg * 8 + 7) * 65 + n]);
    *(uint4*)(dst + (size_t)(drow0 + n) * KP + k0 + kg * 8) = u;
  }
}

DI void adaln_item(const Params& p, int it, char* smem) {
  const int tid = opaque_tid();
  const int l = it / 384, rem = it % 384, cb = rem >> 3, ks = rem & 7;
  float* s = (float*)smem;
  float* red = s + 768;
  __syncthreads();
  for (int i = tid; i < 768; i += 256) {
    int r = i >> 8, k = ks * 256 + (i & 255);
    float cv = (r == 0) ? p.c_ctx[k] : p.c[(r - 1) * D + k];
    s[i] = siluf(cv);
  }
  __syncthreads();
  const int cg4 = tid & 63, kq = tid >> 6;
  const float* W = p.w_ada + (size_t)l * D * MODW + (size_t)(ks * 256 + kq * 64) * MODW + cb * 256 + cg4 * 4;
  float a0[4] = {0, 0, 0, 0}, a1[4] = {0, 0, 0, 0}, a2[4] = {0, 0, 0, 0};
#pragma unroll 8
  for (int k = 0; k < 64; ++k) {
    float4 w = *(const float4*)(W + (size_t)k * MODW);
    float s0 = s[kq * 64 + k], s1 = s[256 + kq * 64 + k], s2 = s[512 + kq * 64 + k];
    a0[0] += s0 * w.x; a0[1] += s0 * w.y; a0[2] += s0 * w.z; a0[3] += s0 * w.w;
    a1[0] += s1 * w.x; a1[1] += s1 * w.y; a1[2] += s1 * w.z; a1[3] += s1 * w.w;
    a2[0] += s2 * w.x; a2[1] += s2 * w.y; a2[2] += s2 * w.z; a2[3] += s2 * w.w;
  }
#pragma unroll
  for (int j = 0; j < 4; ++j) {
    red[(kq * 3 + 0) * 256 + cg4 * 4 + j] = a0[j];
    red[(kq * 3 + 1) * 256 + cg4 * 4 + j] = a1[j];
    red[(kq * 3 + 2) * 256 + cg4 * 4 + j] = a2[j];
  }
  __syncthreads();
  float* mod = (float*)(p.ws + OFF_MOD);
  for (int i = tid; i < 768; i += 256) {
    int r = i >> 8, col = i & 255;
    float v = red[(0 * 3 + r) * 256 + col] + red[(1 * 3 + r) * 256 + col] + red[(2 * 3 + r) * 256 + col] + red[(3 * 3 + r) * 256 + col];
    int n = cb * 256 + col;
    if (ks == 0) v += p.b_ada[l * MODW + n];
    atomicAdd(&mod[(size_t)(l * 3 + r) * MODW + n], v);
  }
}

DI void phase_prep(const Params& p, char* smem) {
  const int G = gridDim.x, bid = blockIdx.x, tid = threadIdx.x;
  char* ws = p.ws;
  for (int it = bid; it < 768; it += G) adaln_item(p, it, smem);
  const int T0 = 3072, T1 = T0 + 1024, T2 = T1 + 1536, T3 = T2 + 1024, T4 = T3 + 5632, T5 = T4 + 5632, T6 = T5 + 2816, T7 = T6 + 2816;
  for (int t = bid; t < T7; t += G) {
    if (t < T0) { int kt = t % 32, nt = t / 32; wt_tile(p.w_in_even, D, EIN, (bf16_t*)(ws + OFF_WIE), DP, kt * 64, nt * 64, nt * 64, smem); }
    else if (t < T1) { int u = t - T0; int kt = u % 32, nt = u / 32; wt_tile(p.w_out_even, D, D, (bf16_t*)(ws + OFF_WOE), DP, kt * 64, nt * 64, nt * 64, smem); }
    else if (t < T2) { int u = t - T1; int kt = u % 32, nt = u / 32; wt_tile(p.w_in_odd, D, OIN, (bf16_t*)(ws + OFF_WIO), DP, kt * 64, nt * 64, nt * 64, smem); }
    else if (t < T3) { int u = t - T2; int kt = u % 32, nt = u / 32; wt_tile(p.w_out_odd, D, D, (bf16_t*)(ws + OFF_WOO), DP, kt * 64, nt * 64, nt * 64, smem); }
    else if (t < T5) {
      int l = (t < T4) ? 0 : 1; int u = t - (l ? T4 : T3); int kt = u % 32, nt = u / 32;
      int drow = (nt < 88) ? nt * 128 : (nt - 88) * 128 + 64;
      wt_tile(p.w_ffn_in + (size_t)l * D * 2 * DFF, D, 2 * DFF, (bf16_t*)(ws + OFF_WFI) + (size_t)l * 2 * DFF * DP, DP, kt * 64, nt * 64, drow, smem);
    } else {
      int l = (t < T6) ? 0 : 1; int u = t - (l ? T6 : T5); int kt = u % 88, nt = u / 88;
      wt_tile(p.w_ffn_out + (size_t)l * DFF * D, DFF, D, (bf16_t*)(ws + OFF_WFO) + (size_t)l * D * FP, FP, kt * 64, nt * 64, nt * 64, smem);
    }
  }
  const size_t gt = (size_t)bid * 256 + tid, gs = (size_t)G * 256;
  {
    bf16_t* d = (bf16_t*)(ws + OFF_KCA);
    for (size_t i = gt; i < (size_t)2 * 512 * 1024 / 4; i += gs) { const float4 v = ((const float4*)p.cache_a_k)[i]; uint2 u; u.x = pack2(v.x, v.y); u.y = pack2(v.z, v.w); ((uint2*)d)[i] = u; }
    bf16_t* d2 = (bf16_t*)(ws + OFF_KCC);
    for (size_t i = gt; i < (size_t)2 * 512 * 512 / 4; i += gs) { const float4 v = ((const float4*)p.cache_c_k)[i]; uint2 u; u.x = pack2(v.x, v.y); u.y = pack2(v.z, v.w); ((uint2*)d2)[i] = u; }
  }
  {
    bf16_t* d = (bf16_t*)(ws + OFF_VTCA);
    for (size_t i = gt; i < (size_t)2 * 512 * 1024; i += gs) {
      int dv = i & 127, h = (i >> 7) & 7, tok = (i >> 10) & 511, b = (int)(i >> 19);
      d[((size_t)(b * 8 + h) * 128 + dv) * 512 + tok] = f2bf(p.cache_a_v[i]);
    }
    bf16_t* d2 = (bf16_t*)(ws + OFF_VTCC);
    for (size_t i = gt; i < (size_t)2 * 512 * 512; i += gs) {
      int dv = i & 127, h = (i >> 7) & 3, tok = (i >> 9) & 511, b = (int)(i >> 18);
      d2[((size_t)(b * 4 + h) * 128 + dv) * 512 + tok] = f2bf(p.cache_c_v[i]);
    }
  }
  {
    bf16_t* d = (bf16_t*)(ws + OFF_WIE);
    for (size_t i = gt; i < (size_t)2 * D * 16; i += gs) {
      int r = i & 15, dd = (i >> 4) & 2047, e = (int)(i >> 15);
      d[(size_t)(EIN + e * 16 + r) * DP + dd] = f2bf(p.w_gate1[i]);
    }
    for (size_t i = gt; i < (size_t)96 * DP / 8; i += gs) ((uint4*)(d + (size_t)(EIN + 32) * DP))[i] = make_uint4(0u, 0u, 0u, 0u);
  }
  {
    float* rt = (float*)(ws + OFF_ROPE);
    for (size_t i = gt; i < 64 * 16; i += gs) {
      int f = i & 15, pos = (int)(i >> 4);
      float inv = powf(10000.f, -(float)(2 * f) / 32.f);
      float a = (float)pos * inv;
      rt[i] = cosf(a); rt[1024 + i] = sinf(a);
    }
    for (size_t i = gt; i < 64 * 32; i += gs) {
      int f = i & 31, pos = (int)(i >> 5);
      float inv = powf(10000.f, -(float)(2 * f) / 64.f);
      float a = (float)pos * inv;
      rt[2048 + i] = cosf(a); rt[2048 + 2048 + i] = sinf(a);
    }
  }
  if (bid == 0 && tid < 64) {
    float a = p.lam_q1[tid] * p.lam_k1[tid], b = p.lam_q2[tid] * p.lam_k2[tid];
    a = wave_sum(a); b = wave_sum(b);
    if (tid == 0) ((float*)(ws + OFF_MISC))[0] = expf(a) - expf(b) + 0.2f;
  }
}

DI void phase_norm(const Params& p, int layer, int which, bool from_input, bool final_norm) {
  const int lane = threadIdx.x & 63, w = threadIdx.x >> 6;
  const float* mod = (const float*)(p.ws + OFF_MOD);
  const bf16_t* Xb = (const bf16_t*)(p.ws + OFF_X);
  bf16_t* H = (bf16_t*)(p.ws + OFF_H);
  const float* g = final_norm ? p.final_norm_g : (p.norm_g + (size_t)(layer * 2 + which) * D);
  float4 ca[8], cb[8];
  int rcur = -1;
  for (int m = blockIdx.x * 4 + w; m < NTOK; m += gridDim.x * 4) {
    const float* x = (m < NP) ? p.x_prompt + (size_t)m * D : p.x_sample + (size_t)(m - NP) * D;
    float4 v[8];
    float ss = 0.f;
#pragma unroll
    for (int i = 0; i < 4; ++i) {
      const int k = (lane + 64 * i) * 8;
      if (from_input) { v[2 * i] = *(const float4*)(x + k); v[2 * i + 1] = *(const float4*)(x + k + 4); }
      else { const uint4 u = *(const uint4*)(Xb + (size_t)m * D + k);
        v[2 * i].x = bf2f(u.x & 0xffff); v[2 * i].y = bf2f(u.x >> 16); v[2 * i].z = bf2f(u.y & 0xffff); v[2 * i].w = bf2f(u.y >> 16);
        v[2 * i + 1].x = bf2f(u.z & 0xffff); v[2 * i + 1].y = bf2f(u.z >> 16); v[2 * i + 1].z = bf2f(u.w & 0xffff); v[2 * i + 1].w = bf2f(u.w >> 16); }
    }
#pragma unroll
    for (int j = 0; j < 8; ++j) ss += v[j].x * v[j].x + v[j].y * v[j].y + v[j].z * v[j].z + v[j].w * v[j].w;
    const int rnew = final_norm ? 0 : modrow(m);
    if (rnew != rcur) {
      rcur = rnew;
      const float* mr = mod + (size_t)(layer * 3 + rnew) * MODW + which * 3 * D;
#pragma unroll
      for (int j = 0; j < 8; ++j) {
        const int k = (lane + 64 * (j >> 1)) * 8 + (j & 1) * 4;
        const float4 gg = *(const float4*)(g + k);
        if (final_norm) { ca[j] = gg; cb[j] = make_float4(0.f, 0.f, 0.f, 0.f); }
        else {
          const float4 sh = *(const float4*)(mr + k);
          const float4 sc = *(const float4*)(mr + D + k);
          ca[j].x = gg.x * (1.f + sc.x); ca[j].y = gg.y * (1.f + sc.y); ca[j].z = gg.z * (1.f + sc.z); ca[j].w = gg.w * (1.f + sc.w);
          cb[j] = sh;
        }
      }
    }
    ss = wave_sum(ss);
    const float rstd = rsqrtf(ss * (1.f / D) + 1e-6f);
    if (final_norm) {
      float* o = p.out + (size_t)m * D;
#pragma unroll
      for (int j = 0; j < 8; ++j) {
        const int k = (lane + 64 * (j >> 1)) * 8 + (j & 1) * 4;
        float4 r; r.x = v[j].x * rstd * ca[j].x; r.y = v[j].y * rstd * ca[j].y; r.z = v[j].z * rstd * ca[j].z; r.w = v[j].w * rstd * ca[j].w;
        *(float4*)(o + k) = r;
      }
    } else {
#pragma unroll
      for (int i = 0; i < 4; ++i) {
        const int k = (lane + 64 * i) * 8;
        uint4 u;
        u.x = pack2(v[2 * i].x * rstd * ca[2 * i].x + cb[2 * i].x, v[2 * i].y * rstd * ca[2 * i].y + cb[2 * i].y);
        u.y = pack2(v[2 * i].z * rstd * ca[2 * i].z + cb[2 * i].z, v[2 * i].w * rstd * ca[2 * i].w + cb[2 * i].w);
        u.z = pack2(v[2 * i + 1].x * rstd * ca[2 * i + 1].x + cb[2 * i + 1].x, v[2 * i + 1].y * rstd * ca[2 * i + 1].y + cb[2 * i + 1].y);
        u.w = pack2(v[2 * i + 1].z * rstd * ca[2 * i + 1].z + cb[2 * i + 1].z, v[2 * i + 1].w * rstd * ca[2 * i + 1].w + cb[2 * i + 1].w);
        *(uint4*)(H + (size_t)m * DP + k) = u;
      }
    }
  }
}

enum { EPI_IN_EVEN = 0, EPI_IN_ODD = 1, EPI_RESID = 2, EPI_SWIGLU = 3 };
constexpr int GA_STRIDE = 144;
constexpr int G_TILE_BYTES = 128 * GA_STRIDE;
constexpr int CS_LD = 132;

struct GemmArgs {
  const bf16_t* A; int lda;
  const bf16_t* Bt; int ldb;
  int K;
  int layer; int which;
  bool x_from_input;
};

DI void rope4(float4& v, const float4& pv, const float* ct, const float* st, int pos, int nf, int f, float sign) {
  const float* c = ct + pos * nf + f; const float* s = st + pos * nf + f;
  v.x = v.x * c[0] + sign * pv.x * s[0];
  v.y = v.y * c[1] + sign * pv.y * s[1];
  v.z = v.z * c[2] + sign * pv.z * s[2];
  v.w = v.w * c[3] + sign * pv.w * s[3];
}

template <int EPI>
DI void gemm_tile(const Params& p, const GemmArgs& ga, int mt, int nt, char* smem) {
  const int tid = opaque_tid(), lane = tid & 63, w = tid >> 6, wm = w >> 1, wn = w & 1;
  const int r = lane & 31, hh = lane >> 5;
  const int m0 = mt * 128, n0 = nt * 128;
  const int K = ga.K, KT = K >> 6;
  const int l15 = lane & 15, quad = lane >> 4;
  f32x4 acc[4][4];
#pragma unroll
  for (int a = 0; a < 4; ++a)
#pragma unroll
    for (int b = 0; b < 4; ++b)
#pragma unroll
      for (int i = 0; i < 4; ++i) acc[a][b][i] = 0.f;

  const int nkt = K >> 6;
  const bf16_t* Asrc[4]; const bf16_t* Bsrc[4];
#pragma unroll
  for (int i = 0; i < 4; ++i) {
    const int c = i * 256 + tid, row = c >> 3, lc = (c & 7) ^ ((row >> 1) & 7);
    Asrc[i] = ga.A + (size_t)(m0 + row) * ga.lda + lc * 8;
    Bsrc[i] = ga.Bt + (size_t)(n0 + row) * ga.ldb + lc * 8;
  }
  const int wbase = __builtin_amdgcn_readfirstlane(w) * 1024;
#define G_STAGE(BUF, KTI) { _Pragma("unroll") for (int i = 0; i < 4; ++i) { \
    __builtin_amdgcn_global_load_lds((const unsigned*)(Asrc[i] + (KTI) * 64), (LAS unsigned*)(smem + (BUF) * 32768 + i * 4096 + wbase), 16, 0, 0); \
    __builtin_amdgcn_global_load_lds((const unsigned*)(Bsrc[i] + (KTI) * 64), (LAS unsigned*)(smem + (BUF) * 32768 + 16384 + i * 4096 + wbase), 16, 0, 0); } }
#define G_WAITV(N) asm volatile("s_waitcnt vmcnt(" #N ")" ::: "memory")
#define G_RAWBAR() { asm volatile("s_waitcnt lgkmcnt(0)" ::: "memory"); __builtin_amdgcn_s_barrier(); }
  int arow[4], brow[4], asw[4], bsw[4];
#pragma unroll
  for (int t = 0; t < 4; ++t) {
    const int ra_ = wm * 64 + t * 16 + l15, rb_ = wn * 64 + t * 16 + l15;
    arow[t] = ra_ * 128; asw[t] = (ra_ >> 1) & 7;
    brow[t] = rb_ * 128 + 16384; bsw[t] = (rb_ >> 1) & 7;
  }
  G_WAITV(0);
  __syncthreads();
  G_STAGE(0, 0);
  G_WAITV(0);
  G_RAWBAR();
  for (int kt = 0; kt < nkt; ++kt) {
    const int cur = kt & 1;
    if (kt + 1 < nkt) G_STAGE(cur ^ 1, kt + 1);
    const char* sS = smem + cur * 32768;
#pragma unroll
    for (int s2 = 0; s2 < 2; ++s2) {
      bf16x8 af[4], bfr[4];
#pragma unroll
      for (int t = 0; t < 4; ++t) {
        af[t] = ld_frag16(sS + arow[t] + (((s2 * 4 + quad) ^ asw[t]) << 4));
        bfr[t] = ld_frag16(sS + brow[t] + (((s2 * 4 + quad) ^ bsw[t]) << 4));
      }
#pragma unroll
      for (int a = 0; a < 4; ++a)
#pragma unroll
        for (int b = 0; b < 4; ++b) acc[a][b] = MFMA16(af[a], bfr[b], acc[a][b]);
    }
    G_WAITV(0);
    G_RAWBAR();
  }
#undef G_STAGE
#undef G_WAITV
#undef G_RAWBAR
  float* Cs = (float*)smem;
#pragma unroll
  for (int a = 0; a < 4; ++a)
#pragma unroll
    for (int b = 0; b < 4; ++b)
#pragma unroll
      for (int i = 0; i < 4; ++i)
        Cs[(wm * 64 + a * 16 + quad * 4 + i) * CS_LD + wn * 64 + b * 16 + l15] = acc[a][b][i];
  __syncthreads();

  if constexpr (EPI == EPI_RESID) {
    const float* mod = (const float*)(p.ws + OFF_MOD);
    bf16_t* Xb = (bf16_t*)(p.ws + OFF_X);
    const int c8 = (tid & 15) * 8;
    const float* gp = mod + (size_t)(ga.layer * 3 + modrow(m0)) * MODW + (ga.which ? 5 : 2) * D + n0 + c8;
    const float4 gt0 = *(const float4*)gp, gt1 = *(const float4*)(gp + 4);
#pragma unroll 4
    for (int ps = 0; ps < 8; ++ps) {
      const int row = ps * 16 + (tid >> 4);
      const int m = m0 + row, n = n0 + c8;
      const float4 v0 = *(const float4*)&Cs[row * CS_LD + c8];
      const float4 v1 = *(const float4*)&Cs[row * CS_LD + c8 + 4];
      float4 x0, x1;
      if (ga.x_from_input) { const float* xp = ((m < NP) ? p.x_prompt + (size_t)m * D : p.x_sample + (size_t)(m - NP) * D) + n;
        x0 = *(const float4*)xp; x1 = *(const float4*)(xp + 4); }
      else { const uint4 u = *(const uint4*)(Xb + (size_t)m * D + n);
        x0.x = bf2f(u.x & 0xffff); x0.y = bf2f(u.x >> 16); x0.z = bf2f(u.y & 0xffff); x0.w = bf2f(u.y >> 16);
        x1.x = bf2f(u.z & 0xffff); x1.y = bf2f(u.z >> 16); x1.z = bf2f(u.w & 0xffff); x1.w = bf2f(u.w >> 16); }
      uint4 o;
      o.x = pack2(x0.x + gt0.x * v0.x, x0.y + gt0.y * v0.y); o.y = pack2(x0.z + gt0.z * v0.z, x0.w + gt0.w * v0.w);
      o.z = pack2(x1.x + gt1.x * v1.x, x1.y + gt1.y * v1.y); o.w = pack2(x1.z + gt1.z * v1.z, x1.w + gt1.w * v1.w);
      *(uint4*)(Xb + (size_t)m * D + n) = o;
    }
  } else if constexpr (EPI == EPI_SWIGLU) {
    bf16_t* act = (bf16_t*)(p.ws + OFF_ACT);
#pragma unroll 4
    for (int ps = 0; ps < 4; ++ps) {
      const int row = ps * 32 + (tid >> 3), j8 = (tid & 7) * 8;
      const float4 g0 = *(const float4*)&Cs[row * CS_LD + j8], g1 = *(const float4*)&Cs[row * CS_LD + j8 + 4];
      const float4 u0 = *(const float4*)&Cs[row * CS_LD + 64 + j8], u1 = *(const float4*)&Cs[row * CS_LD + 64 + j8 + 4];
      uint4 o;
      o.x = pack2(siluf(g0.x) * u0.x, siluf(g0.y) * u0.y); o.y = pack2(siluf(g0.z) * u0.z, siluf(g0.w) * u0.w);
      o.z = pack2(siluf(g1.x) * u1.x, siluf(g1.y) * u1.y); o.w = pack2(siluf(g1.z) * u1.z, siluf(g1.w) * u1.w);
      *(uint4*)(act + (size_t)(m0 + row) * FP + nt * 64 + j8) = o;
    }
  } else if constexpr (EPI == EPI_IN_EVEN) {
    bf16_t* P = (bf16_t*)(p.ws + OFF_P);
    const float* rt = (const float*)(p.ws + OFF_ROPE);
    const bool latent = (m0 >= NP);
    if (nt == 48) {
      float* low = (float*)(p.ws + OFF_LOW);
#pragma unroll 4
      for (int ps = 0; ps < 4; ++ps) {
        const int row = ps * 32 + (tid >> 3), c4 = (tid & 7) * 4;
        *(float4*)(low + (size_t)(m0 + row) * 32 + c4) = *(const float4*)&Cs[row * CS_LD + c4];
      }
    } else {
#pragma unroll 4
      for (int ps = 0; ps < 8; ++ps) {
        const int row = ps * 16 + (tid >> 4), c8 = (tid & 15) * 8;
        const int m = m0 + row, n = n0 + c8;
        float4 v0 = *(const float4*)&Cs[row * CS_LD + c8];
        float4 v1 = *(const float4*)&Cs[row * CS_LD + c8 + 4];
        if (nt >= 8 && nt < 24 && !latent) {
          float* o = p.out + (nt < 16 ? OUT_AK : OUT_AV) + (size_t)m * 1024 + (n - (nt < 16 ? 1024 : 2048));
          *(float4*)o = v0; *(float4*)(o + 4) = v1;
        }
        if (nt < 16 && latent) {
          const int t = (m - NP) & 2047;
          const int d = c8 & 63, j = d & 31;
          const int pos = (d < 32) ? (t >> 6) : (t & 63);
          const float4 pv0 = *(const float4*)&Cs[row * CS_LD + (c8 ^ 16)];
          const float4 pv1 = *(const float4*)&Cs[row * CS_LD + (c8 ^ 16) + 4];
          const float sgn = (j < 16) ? -1.f : 1.f;
          rope4(v0, pv0, rt, rt + 1024, pos, 16, j & 15, sgn);
          rope4(v1, pv1, rt, rt + 1024, pos, 16, (j & 15) + 4, sgn);
        }
        if (!(nt >= 16 && nt < 24) && !(nt >= 32 && nt < 40)) {
          uint4 o; o.x = pack2(v0.x, v0.y); o.y = pack2(v0.z, v0.w); o.z = pack2(v1.x, v1.y); o.w = pack2(v1.z, v1.w);
          *(uint4*)(P + (size_t)m * EINP + n) = o;
        }
      }
      if ((nt >= 16 && nt < 24) || (nt >= 32 && nt < 40)) {
        const int head = (nt < 24) ? nt - 16 : nt - 32;
        bf16_t* base; int L, tok0;
        if (!latent) { const int b = m0 >> 8; tok0 = m0 & 255; L = PSEQ;
          base = (bf16_t*)(p.ws + (nt < 24 ? OFF_VTP : OFF_BVTP)) + (size_t)(b * 8 + head) * 128 * PSEQ; }
        else { const int b = (m0 - NP) >> 11; tok0 = (m0 - NP) & 2047; L = LP;
          base = (bf16_t*)(p.ws + (nt < 24 ? OFF_VTL : OFF_BVTL)) + (size_t)(b * 8 + head) * 128 * LP; }
#pragma unroll 2
        for (int i = 0; i < 8; ++i) {
          const int c = tid + 256 * i, dv = c & 127, tg = c >> 7;
          uint4 u;
          u.x = pack2(Cs[(tg * 8 + 0) * CS_LD + dv], Cs[(tg * 8 + 1) * CS_LD + dv]);
          u.y = pack2(Cs[(tg * 8 + 2) * CS_LD + dv], Cs[(tg * 8 + 3) * CS_LD + dv]);
          u.z = pack2(Cs[(tg * 8 + 4) * CS_LD + dv], Cs[(tg * 8 + 5) * CS_LD + dv]);
          u.w = pack2(Cs[(tg * 8 + 6) * CS_LD + dv], Cs[(tg * 8 + 7) * CS_LD + dv]);
          *(uint4*)(base + (size_t)dv * L + tok0 + tg * 8) = u;
        }
      }
    }
  } else {
    bf16_t* P = (bf16_t*)(p.ws + OFF_P);
    const float* rt = (const float*)(p.ws + OFF_ROPE) + 2048;
    const bool latent = (m0 >= NP);
#pragma unroll 4
    for (int ps = 0; ps < 8; ++ps) {
      const int row = ps * 16 + (tid >> 4), c8 = (tid & 15) * 8;
      const int m = m0 + row, n = n0 + c8;
      float4 v0 = *(const float4*)&Cs[row * CS_LD + c8];
      float4 v1 = *(const float4*)&Cs[row * CS_LD + c8 + 4];
      if (nt >= 16 && !latent) {
        float* o = p.out + (nt < 20 ? OUT_CK : OUT_CV) + (size_t)m * 512 + (n - (nt < 20 ? 2048 : 2560));
        *(float4*)o = v0; *(float4*)(o + 4) = v1;
      }
      if (nt < 20 && latent) {
        const int t = (m - NP) & 2047;
        const int d = c8, j = d & 63;
        const int pos = (d < 64) ? (t >> 6) : (t & 63);
        const float4 pv0 = *(const float4*)&Cs[row * CS_LD + (c8 ^ 32)];
        const float4 pv1 = *(const float4*)&Cs[row * CS_LD + (c8 ^ 32) + 4];
        const float sgn = (j < 32) ? -1.f : 1.f;
        rope4(v0, pv0, rt, rt + 2048, pos, 32, j & 31, sgn);
        rope4(v1, pv1, rt, rt + 2048, pos, 32, (j & 31) + 4, sgn);
      }
      if (nt < 20) {
        uint4 o; o.x = pack2(v0.x, v0.y); o.y = pack2(v0.z, v0.w); o.z = pack2(v1.x, v1.y); o.w = pack2(v1.z, v1.w);
        *(uint4*)(P + (size_t)m * OIN + n) = o;
      }
    }
    if (nt >= 20) {
      const int head = nt - 20;
      bf16_t* base; int L, tok0;
      if (!latent) { const int b = m0 >> 8; tok0 = m0 & 255; L = PSEQ; base = (bf16_t*)(p.ws + OFF_VTP) + (size_t)(b * 4 + head) * 128 * PSEQ; }
      else { const int b = (m0 - NP) >> 11; tok0 = (m0 - NP) & 2047; L = LP; base = (bf16_t*)(p.ws + OFF_VTL) + (size_t)(b * 4 + head) * 128 * LP; }
#pragma unroll 2
      for (int i = 0; i < 8; ++i) {
        const int c = tid + 256 * i, dv = c & 127, tg = c >> 7;
        uint4 u;
        u.x = pack2(Cs[(tg * 8 + 0) * CS_LD + dv], Cs[(tg * 8 + 1) * CS_LD + dv]);
        u.y = pack2(Cs[(tg * 8 + 2) * CS_LD + dv], Cs[(tg * 8 + 3) * CS_LD + dv]);
        u.z = pack2(Cs[(tg * 8 + 4) * CS_LD + dv], Cs[(tg * 8 + 5) * CS_LD + dv]);
        u.w = pack2(Cs[(tg * 8 + 6) * CS_LD + dv], Cs[(tg * 8 + 7) * CS_LD + dv]);
        *(uint4*)(base + (size_t)dv * L + tok0 + tg * 8) = u;
      }
    }
  }
}

template <int EPI>
DI void phase_gemm(const Params& p, const GemmArgs& ga, int Nt, int extra_nt, char* smem) {
  const int G = gridDim.x, bid = blockIdx.x;
  constexpr int Mt = NTOK / 128;
  if ((G & 63) == 0) {
    const int S = G >> 3, SM = S >> 3;
    const int xcd = bid & 7, slot = bid >> 3;
    const int nsm = Mt / SM, nsn = Nt >> 3;
    const int nsuper = nsm * nsn;
    const int lm = slot % SM, ln = slot / SM;
    for (int sid = xcd; sid < nsuper; sid += 8) {
      const int sm = sid % nsm, sn = sid / nsm;
      gemm_tile<EPI>(p, ga, sm * SM + lm, sn * 8 + ln, smem);
    }
  } else {
    for (int t = bid; t < Mt * Nt; t += G) gemm_tile<EPI>(p, ga, t % Mt, t / Mt, smem);
  }
  if (extra_nt >= 0) {
    for (int t = bid; t < Mt; t += G) gemm_tile<EPI>(p, ga, t, extra_nt, smem);
  }
}

template <int DQK, bool OUTBF>
DI void attn_item(const bf16_t* Q, int qstride,
                  const bf16_t* K0, int k0s, const bf16_t* Vt0, int vt0s, int n0,
                  const bf16_t* K1, int k1s, const bf16_t* Vt1, int vt1s, int s1, int e1,
                  float scl2, bool has_sink, float sink2, bool window, int qpos0,
                  void* Out, int ostride, char* smem) {
  constexpr int KST = DQK * 2 + 16;
  constexpr int KCH = DQK / 8;
  constexpr int KPT = DQK / 32;
  constexpr int NS = DQK / 16;
  const int tid = opaque_tid(), lane = tid & 63, w = tid >> 6, r = lane & 31, hh = lane >> 5;
  char* sK = smem; char* sV = smem + 64 * KST;
  constexpr bool QLDS = (DQK == 128);
  constexpr int NQF = QLDS ? 1 : NS;
  char* sQ = smem + 64 * KST + 128 * 144;
  bf16x8 qf[NQF];
  if constexpr (QLDS) {
    __syncthreads();
#pragma unroll
    for (int j = 0; j < 8; ++j) { int c = tid + 256 * j; int row = c >> 4, kc = c & 15;
      *(u32x4*)(sQ + row * KST + kc * 16) = *(const u32x4*)(Q + (size_t)row * qstride + kc * 8); }
  } else {
#pragma unroll
    for (int s = 0; s < NS; ++s) qf[s] = *(const bf16x8*)(Q + (size_t)(w * 32 + r) * qstride + s * 16 + hh * 8);
  }
  f32x16 OT[4];
#pragma unroll
  for (int t = 0; t < 4; ++t)
#pragma unroll
    for (int i = 0; i < 16; ++i) OT[t][i] = 0.f;
  float mrun = has_sink ? sink2 : -1e30f;
  float lrun = (has_sink && hh == 0) ? 1.f : 0.f;
  const int nt0 = n0 >> 6, NT = nt0 + ((e1 - s1) >> 6);
  u32x4 rk[KPT], rv[4];
  auto prefetch = [&](int T) {
    const bf16_t* Kp; const bf16_t* Vp; int ks, vs, key0;
    if (T < nt0) { Kp = K0; Vp = Vt0; ks = k0s; vs = vt0s; key0 = T * 64; }
    else { Kp = K1; Vp = Vt1; ks = k1s; vs = vt1s; key0 = s1 + (T - nt0) * 64; }
#pragma unroll
    for (int j = 0; j < KPT; ++j) { int c = tid + 256 * j; int row = c / KCH, kc = c % KCH; rk[j] = *(const u32x4*)(Kp + (size_t)(key0 + row) * ks + kc * 8); }
#pragma unroll
    for (int j = 0; j < 4; ++j) { int c = tid + 256 * j; int dv = c >> 3, kc = c & 7; rv[j] = *(const u32x4*)(Vp + (size_t)dv * vs + key0 + kc * 8); }
  };
  prefetch(0);
  for (int T = 0; T < NT; ++T) {
    __syncthreads();
#pragma unroll
    for (int j = 0; j < KPT; ++j) { int c = tid + 256 * j; int row = c / KCH, kc = c % KCH; *(u32x4*)(sK + row * KST + kc * 16) = rk[j]; }
#pragma unroll
    for (int j = 0; j < 4; ++j) { int c = tid + 256 * j; int dv = c >> 3, kc = c & 7; *(u32x4*)(sV + dv * 144 + kc * 16) = rv[j]; }
    __syncthreads();
    if (T + 1 < NT) prefetch(T + 1);
    f32x16 ST[2];
#pragma unroll
    for (int k2 = 0; k2 < 2; ++k2) {
#pragma unroll
      for (int i = 0; i < 16; ++i) ST[k2][i] = 0.f;
#pragma unroll
      for (int s = 0; s < NS; ++s) {
        bf16x8 kf = ld_frag16(sK + (k2 * 32 + r) * KST + (s * 16 + hh * 8) * 2);
        bf16x8 qv;
        if constexpr (QLDS) qv = ld_frag16(sQ + (w * 32 + r) * KST + (s * 16 + hh * 8) * 2); else qv = qf[s];
        ST[k2] = MFMA32(kf, qv, ST[k2]);
      }
      __builtin_amdgcn_sched_barrier(0);
    }
    const bool domask = window && (T >= nt0);
    const int key0w = s1 + (T - nt0) * 64;
    const int qpos = qpos0 + w * 32 + r;
    float tmax = -1e30f;
#pragma unroll
    for (int k2 = 0; k2 < 2; ++k2)
#pragma unroll
      for (int i = 0; i < 16; ++i) {
        float v = ST[k2][i];
        if (domask) { int kpos = key0w + k2 * 32 + crow(i, hh); int dd = qpos - kpos; if (dd > 128 || dd < -128) v = -1e30f; }
        ST[k2][i] = v; tmax = fmaxf(tmax, v);
      }
    tmax = fmaxf(tmax, __shfl_xor(tmax, 32, 64));
    const float mnew = fmaxf(mrun, tmax * scl2);
    const float alpha = __builtin_amdgcn_exp2f(mrun - mnew);
    mrun = mnew;
    float ls = 0.f;
#pragma unroll
    for (int k2 = 0; k2 < 2; ++k2)
#pragma unroll
      for (int i = 0; i < 16; ++i) { float pv = __builtin_amdgcn_exp2f(fmaf(ST[k2][i], scl2, -mnew)); ST[k2][i] = pv; ls += pv; }
    lrun = lrun * alpha + ls;
    __builtin_amdgcn_sched_barrier(0);
    if (__any(alpha != 1.f)) {
#pragma unroll
      for (int t = 0; t < 4; ++t)
#pragma unroll
        for (int i = 0; i < 16; ++i) OT[t][i] *= alpha;
    }
#pragma unroll
    for (int k2 = 0; k2 < 2; ++k2)
#pragma unroll
      for (int s = 0; s < 2; ++s) {
        bf16x8 pf = pack8(ST[k2], s);
#pragma unroll
        for (int t = 0; t < 4; ++t) {
          bf16x8 vf = ld_frag8x2(sV + (t * 32 + r) * 144 + (k2 * 32 + 16 * s + 4 * hh) * 2);
          OT[t] = MFMA32(vf, pf, OT[t]);
        }
        __builtin_amdgcn_sched_barrier(0);
      }
  }
  float ltot = lrun + __shfl_xor(lrun, 32, 64);
  const float inv = 1.f / ltot;
  const int q = w * 32 + r;
#pragma unroll
  for (int t = 0; t < 4; ++t)
#pragma unroll
    for (int g4 = 0; g4 < 4; ++g4) {
      const int dv = t * 32 + 8 * g4 + 4 * hh;
      float a = OT[t][4 * g4 + 0] * inv, b = OT[t][4 * g4 + 1] * inv, c = OT[t][4 * g4 + 2] * inv, d = OT[t][4 * g4 + 3] * inv;
      if constexpr (OUTBF) { uint2 u; u.x = pack2(a, b); u.y = pack2(c, d); *(uint2*)((bf16_t*)Out + (size_t)q * ostride + dv) = u; }
      else { float4 o; o.x = a; o.y = b; o.z = c; o.w = d; *(float4*)((float*)Out + (size_t)q * ostride + dv) = o; }
    }
}

constexpr size_t GLA_ITEM_BYTES = 16384 + 8192 + 256;
constexpr int GLA_NITEMS = 1024 + 2048;
static_assert((size_t)GLA_NITEMS * GLA_ITEM_BYTES <= (size_t)NTOK * D * 4, "gla scratch");
DI int gla_item_index(int seq, int head, int dir, int c) {
  return (seq >= 32) ? ((((seq - 32) * 8 + head) * 2 + dir) * 32 + c) : (1024 + (((seq * 8 + head) * 2 + dir) * 4 + c));
}

DI void gla_prep_item(const Params& p, int seq, int head, int dir, int c, char* smem) {
  const int tid = opaque_tid(), lane = tid & 63, w = tid >> 6, r = lane & 31, hh = lane >> 5;
  const bool latent = seq >= 32;
  const int L = latent ? LSEQ : PSEQ;
  const int tokbase = latent ? NP + (seq - 32) * LSEQ : seq * PSEQ;
  const bf16_t* P = (const bf16_t*)(p.ws + OFF_P);
  const float* LOW = (const float*)(p.ws + OFF_LOW);
  const int vpitch = latent ? LP : PSEQ;
  const bf16_t* Vt = latent ? (const bf16_t*)(p.ws + OFF_BVTL) + (size_t)((seq - 32) * 8 + head) * 128 * LP
                            : (const bf16_t*)(p.ws + OFF_BVTP) + (size_t)(seq * 8 + head) * 128 * PSEQ;
  bf16_t* GO = (bf16_t*)(p.ws + OFF_GO) + (size_t)dir * NTOK * 1024;
  char* gscr = p.ws + OFF_X + (size_t)gla_item_index(seq, head, dir, c) * GLA_ITEM_BYTES;
  char* s_qin = smem;
  char* s_kin = smem + 9216;
  char* s_ket = smem + 18432;
  char* s_vt  = smem + 27648;
  float* s_low = (float*)(smem + 46080);
  float* s_seg = (float*)(smem + 50176);
  float* s_dec = (float*)(smem + 51200);
  const int dk = lane, seg = w;
  float* s_wv = (float*)(smem + 51456);
  float* s_b = (float*)(smem + 55552);
  bf16_t* s_q = (bf16_t*)(smem + 18432);
  const int lt0 = (dir == 0) ? c * 64 : L - 64 * (c + 1);
  const int tok0 = tokbase + lt0;
  __syncthreads();
  {
#pragma unroll
    for (int j = 0; j < 4; ++j) { int idx = tid + 256 * j; s_wv[idx] = p.w_gate2[(size_t)(dir * 16 + (idx >> 6)) * 512 + head * 64 + (idx & 63)]; }
    const int i = tid >> 2, r4 = (tid & 3) * 4;
    *(float4*)(s_low + i * 16 + r4) = *(const float4*)(LOW + (size_t)(tok0 + i) * 32 + dir * 16 + r4);
#pragma unroll
    for (int j = 0; j < 4; ++j) { int cc = tid + 256 * j; int dv = cc >> 3, kc = cc & 7;
      *(uint4*)(s_vt + dv * 144 + kc * 16) = *(const uint4*)(Vt + (size_t)dv * vpitch + lt0 + kc * 8); }
#pragma unroll
    for (int j = 0; j < 2; ++j) { int cc = tid + 256 * j; int row = cc >> 3, kc = cc & 7;
      *(uint4*)(s_qin + row * 144 + kc * 16) = *(const uint4*)(P + (size_t)(tok0 + row) * EINP + 3072 + head * 64 + kc * 8);
      *(uint4*)(s_kin + row * 144 + kc * 16) = *(const uint4*)(P + (size_t)(tok0 + row) * EINP + 3584 + head * 64 + kc * 8); }
  }
  const float bias = p.b_gate[dir * 512 + head * 64 + dk];
  __syncthreads();
  {
    float run = 0.f;
    float wv[16];
#pragma unroll
    for (int j = 0; j < 16; ++j) wv[j] = s_wv[j * 64 + dk];
#pragma unroll 4
    for (int tt = 0; tt < 16; ++tt) {
      const int t = (dir == 0) ? tt : 15 - tt;
      const float* lw = s_low + (seg * 16 + t) * 16;
      float lg = bias;
#pragma unroll
      for (int j = 0; j < 16; ++j) lg += lw[j] * wv[j];
      run += (fminf(lg, 0.f) - __logf(1.f + __expf(-fabsf(lg)))) * (1.f / 16.f);
      s_b[(seg * 16 + t) * 64 + dk] = run;
    }
    s_seg[seg * 64 + dk] = run;
  }
  __syncthreads();
  float pre = 0.f, btot = 0.f;
#pragma unroll
  for (int s = 0; s < 4; ++s) {
    float v = s_seg[s * 64 + dk];
    btot += v;
    if ((dir == 0 && s < seg) || (dir == 1 && s > seg)) pre += v;
  }
#pragma unroll 4
  for (int t = 0; t < 16; ++t) {
    const int i = seg * 16 + t;
    const float b = pre + s_b[i * 64 + dk];
    const float qv = bf2f(*(const unsigned short*)(s_qin + i * 144 + dk * 2));
    const float kv = bf2f(*(const unsigned short*)(s_kin + i * 144 + dk * 2));
    *(unsigned short*)(s_qin + i * 144 + dk * 2) = f2bf(qv * 0.125f * __expf(b));
    *(unsigned short*)(s_kin + i * 144 + dk * 2) = f2bf(kv * __expf(-b));
    *(unsigned short*)(s_ket + dk * 144 + i * 2) = f2bf(kv * __expf(btot - b));
  }
  if (seg == 0) { const float dcy = __expf(btot); s_dec[dk] = dcy; ((float*)(gscr + 24576))[dk] = dcy; }
  __syncthreads();
#pragma unroll
  for (int j = 0; j < 2; ++j) { int cc = tid + 256 * j; int row = cc >> 3, kc = cc & 7;
    *(uint4*)(gscr + 16384 + row * 128 + kc * 16) = *(const uint4*)(s_qin + row * 144 + kc * 16); }
  f32x16 OT[2];
#pragma unroll
  for (int b = 0; b < 2; ++b)
#pragma unroll
    for (int i = 0; i < 16; ++i) OT[b][i] = 0.f;
#pragma unroll
  for (int a = 0; a < 2; ++a) {
    f32x16 AT[2];
#pragma unroll
    for (int b = 0; b < 2; ++b)
#pragma unroll
      for (int i = 0; i < 16; ++i) AT[b][i] = 0.f;
#pragma unroll
    for (int s = 0; s < 4; ++s) {
      bf16x8 kf = ld_frag16(s_kin + (a * 32 + r) * 144 + (s * 16 + hh * 8) * 2);
#pragma unroll
      for (int b = 0; b < 2; ++b) {
        bf16x8 qf = ld_frag16(s_qin + (b * 32 + r) * 144 + (s * 16 + hh * 8) * 2);
        AT[b] = MFMA32(kf, qf, AT[b]);
      }
    }
#pragma unroll
    for (int b = 0; b < 2; ++b)
#pragma unroll
      for (int i = 0; i < 16; ++i) {
        const int j = a * 32 + crow(i, hh), ii = b * 32 + r;
        const bool keep = (dir == 0) ? (j <= ii) : (j >= ii);
        if (!keep) AT[b][i] = 0.f;
      }
#pragma unroll
    for (int s2 = 0; s2 < 2; ++s2) {
      bf16x8 vf = ld_frag8x2(s_vt + (w * 32 + r) * 144 + (a * 32 + 16 * s2 + 4 * hh) * 2);
#pragma unroll
      for (int b = 0; b < 2; ++b) OT[b] = MFMA32(vf, pack8(AT[b], s2), OT[b]);
    }
  }
#pragma unroll
  for (int b = 0; b < 2; ++b)
#pragma unroll
    for (int g4 = 0; g4 < 4; ++g4) {
      uint2 o; o.x = pack2(OT[b][4 * g4], OT[b][4 * g4 + 1]); o.y = pack2(OT[b][4 * g4 + 2], OT[b][4 * g4 + 3]);
      *(uint2*)(GO + (size_t)(tok0 + b * 32 + r) * 1024 + head * 128 + w * 32 + 8 * g4 + 4 * hh) = o;
    }
#pragma unroll
  for (int T = 0; T < 2; ++T) {
    f32x16 KV;
#pragma unroll
    for (int i = 0; i < 16; ++i) KV[i] = 0.f;
#pragma unroll
    for (int s = 0; s < 4; ++s) {
      bf16x8 af = ld_frag16(s_ket + (T * 32 + r) * 144 + (s * 16 + hh * 8) * 2);
      bf16x8 bv = ld_frag16(s_vt + (w * 32 + r) * 144 + (s * 16 + hh * 8) * 2);
      KV = MFMA32(af, bv, KV);
    }
    *(bf16x8*)(gscr + ((T * 4 + w) * 64 + lane) * 32) = pack8(KV, 0);
    *(bf16x8*)(gscr + ((T * 4 + w) * 64 + lane) * 32 + 16) = pack8(KV, 1);
  }
}

DI void gla_chain_wave(const Params& p, int chain, int wt) {
  const int lane = threadIdx.x & 63, r = lane & 31, hh = lane >> 5;
  const bool latent = chain < 32;
  int seq, head, dir;
  if (latent) { dir = chain & 1; head = (chain >> 1) & 7; seq = 32 + (chain >> 4); }
  else { const int cc = chain - 32; dir = cc & 1; head = (cc >> 1) & 7; seq = cc >> 4; }
  const int nchunks = latent ? 32 : 4;
  char* gbase = p.ws + OFF_X + (size_t)gla_item_index(seq, head, dir, 0) * GLA_ITEM_BYTES;
  f32x16 S[2];
#pragma unroll
  for (int T = 0; T < 2; ++T)
#pragma unroll
    for (int i = 0; i < 16; ++i) {
      float v = 0.f;
      if (latent) v = p.state_b[((size_t)(((seq - 32) * 2 + dir) * 8 + head) * 64 + T * 32 + crow(i, hh)) * 128 + wt * 32 + r];
      S[T][i] = v;
    }
  bf16x8 kvf[2][2]; float4 dc[2][4];
#define CH_LOAD(G) { _Pragma("unroll") for (int T = 0; T < 2; ++T) { \
      kvf[T][0] = *(const bf16x8*)((G) + ((T * 4 + wt) * 64 + lane) * 32); \
      kvf[T][1] = *(const bf16x8*)((G) + ((T * 4 + wt) * 64 + lane) * 32 + 16); \
      _Pragma("unroll") for (int g4 = 0; g4 < 4; ++g4) dc[T][g4] = *(const float4*)((G) + 24576 + (T * 32 + 8 * g4 + 4 * hh) * 4); } }
  CH_LOAD(gbase);
  for (int c = 0; c < nchunks; ++c) {
    char* g = gbase + (size_t)c * GLA_ITEM_BYTES;
    bf16x8 kc[2][2]; float4 dcc[2][4];
#pragma unroll
    for (int T = 0; T < 2; ++T) { kc[T][0] = kvf[T][0]; kc[T][1] = kvf[T][1];
#pragma unroll
      for (int g4 = 0; g4 < 4; ++g4) dcc[T][g4] = dc[T][g4]; }
    if (c + 1 < nchunks) CH_LOAD(g + GLA_ITEM_BYTES);
#pragma unroll
    for (int T = 0; T < 2; ++T) {
      *(bf16x8*)(g + ((T * 4 + wt) * 64 + lane) * 32) = pack8(S[T], 0);
      *(bf16x8*)(g + ((T * 4 + wt) * 64 + lane) * 32 + 16) = pack8(S[T], 1);
#pragma unroll
      for (int g4 = 0; g4 < 4; ++g4) {
        S[T][4 * g4]     = S[T][4 * g4]     * dcc[T][g4].x + bf2f((unsigned short)kc[T][g4 >> 1][(g4 & 1) * 4 + 0]);
        S[T][4 * g4 + 1] = S[T][4 * g4 + 1] * dcc[T][g4].y + bf2f((unsigned short)kc[T][g4 >> 1][(g4 & 1) * 4 + 1]);
        S[T][4 * g4 + 2] = S[T][4 * g4 + 2] * dcc[T][g4].z + bf2f((unsigned short)kc[T][g4 >> 1][(g4 & 1) * 4 + 2]);
        S[T][4 * g4 + 3] = S[T][4 * g4 + 3] * dcc[T][g4].w + bf2f((unsigned short)kc[T][g4 >> 1][(g4 & 1) * 4 + 3]);
      }
    }
  }
#undef CH_LOAD
  if (!latent) {
    float* o = p.out + OUT_SB + (size_t)((seq * 2 + dir) * 8 + head) * 64 * 128;
#pragma unroll
    for (int T = 0; T < 2; ++T)
#pragma unroll
      for (int i = 0; i < 16; ++i) o[(size_t)(T * 32 + crow(i, hh)) * 128 + wt * 32 + r] = S[T][i];
  }
}

DI void phase_gla_chain(const Params& p) {
  const int w = threadIdx.x >> 6;
  const int nw = gridDim.x * 4;
  for (int id = blockIdx.x * 4 + w; id < 544 * 4; id += nw) gla_chain_wave(p, id >> 2, id & 3);
}

DI void gla_inter_wave(const Params& p, int item, int wt) {
  const int lane = threadIdx.x & 63, r = lane & 31, hh = lane >> 5;
  int seq, head, dir, c;
  if (item < 1024) { c = item & 31; const int ch = item >> 5; dir = ch & 1; head = (ch >> 1) & 7; seq = 32 + (ch >> 4); }
  else { const int jj = item - 1024; c = jj & 3; const int ch = jj >> 2; dir = ch & 1; head = (ch >> 1) & 7; seq = ch >> 4; }
  const bool latent = seq >= 32;
  const int L = latent ? LSEQ : PSEQ;
  const int tokbase = latent ? NP + (seq - 32) * LSEQ : seq * PSEQ;
  const int lt0 = (dir == 0) ? c * 64 : L - 64 * (c + 1);
  const int tok0 = tokbase + lt0;
  bf16_t* GO = (bf16_t*)(p.ws + OFF_GO) + (size_t)dir * NTOK * 1024;
  const char* g = p.ws + OFF_X + (size_t)item * GLA_ITEM_BYTES;
  f32x16 OT[2];
#pragma unroll
  for (int b = 0; b < 2; ++b)
#pragma unroll
    for (int g4 = 0; g4 < 4; ++g4) {
      const uint2 o = *(const uint2*)(GO + (size_t)(tok0 + b * 32 + r) * 1024 + head * 128 + wt * 32 + 8 * g4 + 4 * hh);
      OT[b][4 * g4] = bf2f(o.x & 0xffff); OT[b][4 * g4 + 1] = bf2f(o.x >> 16); OT[b][4 * g4 + 2] = bf2f(o.y & 0xffff); OT[b][4 * g4 + 3] = bf2f(o.y >> 16);
    }
#pragma unroll
  for (int T = 0; T < 2; ++T)
#pragma unroll
    for (int s2 = 0; s2 < 2; ++s2) {
      bf16x8 sf = *(const bf16x8*)(g + ((T * 4 + wt) * 64 + lane) * 32 + s2 * 16);
#pragma unroll
      for (int b = 0; b < 2; ++b) {
        const char* qp = g + 16384 + (b * 32 + r) * 128 + (T * 32 + 16 * s2 + 4 * hh) * 2;
        s16x4 lo = *(const s16x4*)qp; s16x4 hi = *(const s16x4*)(qp + 16);
        bf16x8 qf = __builtin_shufflevector(lo, hi, 0, 1, 2, 3, 4, 5, 6, 7);
        OT[b] = MFMA32(sf, qf, OT[b]);
      }
    }
#pragma unroll
  for (int b = 0; b < 2; ++b)
#pragma unroll
    for (int g4 = 0; g4 < 4; ++g4) {
      uint2 o; o.x = pack2(OT[b][4 * g4], OT[b][4 * g4 + 1]); o.y = pack2(OT[b][4 * g4 + 2], OT[b][4 * g4 + 3]);
      *(uint2*)(GO + (size_t)(tok0 + b * 32 + r) * 1024 + head * 128 + wt * 32 + 8 * g4 + 4 * hh) = o;
    }
}

DI void phase_gla_inter(const Params& p) {
  const int w = threadIdx.x >> 6;
  const int nw = gridDim.x * 4;
  for (int id = blockIdx.x * 4 + w; id < GLA_NITEMS * 4; id += nw) gla_inter_wave(p, id >> 2, id & 3);
}

DI int next_item(int* counter, int* s_item) {
  __syncthreads();
  if (threadIdx.x == 0) *s_item = atomicAdd(counter, 1);
  __syncthreads();
  return __builtin_amdgcn_readfirstlane(*s_item);
}

constexpr float LOG2E = 1.4426950408889634f;

DI void phase_mixer_even(const Params& p, char* smem, int* s_item) {
  int* counter = (int*)(p.ws + OFF_CNT) + 0;
  const bf16_t* P = (const bf16_t*)(p.ws + OFF_P);
  bf16_t* OD = (bf16_t*)(p.ws + OFF_OD);
  const float scl2 = 0.125f * LOG2E;
  for (;;) {
    const int id = next_item(counter, s_item);
    if (id >= 512 + 1024 + GLA_NITEMS) break;
    if (id < 512) {
      const int j = id; const int qb = j & 15, map = (j >> 4) & 1, head = (j >> 5) & 7, b = j >> 8;
      const int m0 = NP + b * LSEQ + qb * 128;
      attn_item<64, true>(P + (size_t)m0 * EINP + head * 128 + map * 64, EINP,
                           (const bf16_t*)(p.ws + OFF_KCA) + (size_t)b * 512 * 1024 + head * 128 + map * 64, 1024,
                           (const bf16_t*)(p.ws + OFF_VTCA) + (size_t)(b * 8 + head) * 128 * 512, 512, 512,
                           P + (size_t)(NP + b * LSEQ) * EINP + 1024 + head * 128 + map * 64, EINP,
                           (const bf16_t*)(p.ws + OFF_VTL) + (size_t)(b * 8 + head) * 128 * LP, LP, 0, LSEQ,
                           scl2, false, 0.f, false, 0,
                           OD + ((size_t)m0 * 2 + map) * 1024 + head * 128, 2048, smem);
    } else if (id < 512 + GLA_NITEMS) {
      const int j = id - 512;
      if (j < 1024) { const int c = j & 31, ch = j >> 5; gla_prep_item(p, 32 + (ch >> 4), (ch >> 1) & 7, ch & 1, c, smem); }
      else { const int jj = j - 1024; const int c = jj & 3, ch = jj >> 2; gla_prep_item(p, ch >> 4, (ch >> 1) & 7, ch & 1, c, smem); }
    } else {
      const int j = id - 512 - GLA_NITEMS; const int qb = j & 1, map = (j >> 1) & 1, head = (j >> 2) & 7, b = j >> 5;
      const int m0 = b * PSEQ + qb * 128;
      attn_item<64, true>(P + (size_t)m0 * EINP + head * 128 + map * 64, EINP,
                           nullptr, 0, nullptr, 0, 0,
                           P + (size_t)(b * PSEQ) * EINP + 1024 + head * 128 + map * 64, EINP,
                           (const bf16_t*)(p.ws + OFF_VTP) + (size_t)(b * 8 + head) * 128 * PSEQ, PSEQ, 0, PSEQ,
                           scl2, false, 0.f, false, 0,
                           OD + ((size_t)m0 * 2 + map) * 1024 + head * 128, 2048, smem);
    }
  }
}

DI void phase_yprep_even(const Params& p) {
  const int lane = threadIdx.x & 63, w = threadIdx.x >> 6, hq = lane >> 4, l16 = lane & 15;
  const float lam = ((const float*)(p.ws + OFF_MISC))[0];
  const bf16_t* OD = (const bf16_t*)(p.ws + OFF_OD);
  const bf16_t* GO = (const bf16_t*)(p.ws + OFF_GO);
  const bf16_t* P = (const bf16_t*)(p.ws + OFF_P);
  bf16_t* Y = (bf16_t*)(p.ws + OFF_H);
  float sg[8], gg[8];
#pragma unroll
  for (int j = 0; j < 8; ++j) { sg[j] = p.subln_g[l16 * 8 + j]; gg[j] = p.gla_norm_g[l16 * 8 + j]; }
#define UNPK8(U, F) { F[0] = bf2f(U.x & 0xffff); F[1] = bf2f(U.x >> 16); F[2] = bf2f(U.y & 0xffff); F[3] = bf2f(U.y >> 16); \
                      F[4] = bf2f(U.z & 0xffff); F[5] = bf2f(U.z >> 16); F[6] = bf2f(U.w & 0xffff); F[7] = bf2f(U.w >> 16); }
  for (int tok = blockIdx.x * 4 + w; tok < NTOK; tok += gridDim.x * 4) {
#pragma unroll
    for (int hp = 0; hp < 2; ++hp) {
      const int head = hp * 4 + hq;
      const uint4 ua = *(const uint4*)(OD + ((size_t)tok * 2 + 0) * 1024 + head * 128 + l16 * 8);
      const uint4 ub = *(const uint4*)(OD + ((size_t)tok * 2 + 1) * 1024 + head * 128 + l16 * 8);
      float a[8], b[8], o[8];
      UNPK8(ua, a); UNPK8(ub, b);
      float ss = 0.f;
#pragma unroll
      for (int j = 0; j < 8; ++j) { o[j] = a[j] - lam * b[j]; ss += o[j] * o[j]; }
#pragma unroll
      for (int off = 8; off >= 1; off >>= 1) ss += __shfl_xor(ss, off, 64);
      const float rs = rsqrtf(ss * (1.f / 128.f) + 1e-6f) * 0.8f;
      uint4 u;
      u.x = pack2(o[0] * rs * sg[0], o[1] * rs * sg[1]); u.y = pack2(o[2] * rs * sg[2], o[3] * rs * sg[3]);
      u.z = pack2(o[4] * rs * sg[4], o[5] * rs * sg[5]); u.w = pack2(o[6] * rs * sg[6], o[7] * rs * sg[7]);
      *(uint4*)(Y + (size_t)tok * DP + head * 128 + l16 * 8) = u;
    }
#pragma unroll
    for (int hp = 0; hp < 2; ++hp) {
      const int head = hp * 4 + hq;
      const uint4 ua = *(const uint4*)(GO + (size_t)tok * 1024 + head * 128 + l16 * 8);
      const uint4 ub = *(const uint4*)(GO + (size_t)NTOK * 1024 + (size_t)tok * 1024 + head * 128 + l16 * 8);
      const uint4 ur = *(const uint4*)(P + (size_t)tok * EINP + 5120 + head * 128 + l16 * 8);
      float a[8], b[8], br[8], o[8];
      UNPK8(ua, a); UNPK8(ub, b); UNPK8(ur, br);
      float ss = 0.f;
#pragma unroll
      for (int j = 0; j < 8; ++j) { o[j] = a[j] + b[j]; ss += o[j] * o[j]; }
#pragma unroll
      for (int off = 8; off >= 1; off >>= 1) ss += __shfl_xor(ss, off, 64);
      const float rs = rsqrtf(ss * (1.f / 128.f) + 1e-6f);
      uint4 u;
      u.x = pack2(o[0] * rs * gg[0] * siluf(br[0]), o[1] * rs * gg[1] * siluf(br[1]));
      u.y = pack2(o[2] * rs * gg[2] * siluf(br[2]), o[3] * rs * gg[3] * siluf(br[3]));
      u.z = pack2(o[4] * rs * gg[4] * siluf(br[4]), o[5] * rs * gg[5] * siluf(br[5]));
      u.w = pack2(o[6] * rs * gg[6] * siluf(br[6]), o[7] * rs * gg[7] * siluf(br[7]));
      *(uint4*)(Y + (size_t)tok * DP + 1024 + head * 128 + l16 * 8) = u;
    }
  }
#undef UNPK8
}

DI void phase_attn_odd(const Params& p, char* smem, int* s_item) {
  int* counter = (int*)(p.ws + OFF_CNT) + 1;
  const bf16_t* P = (const bf16_t*)(p.ws + OFF_P);
  bf16_t* Y = (bf16_t*)(p.ws + OFF_H);
  const float scl2 = 0.08838834764831845f * LOG2E;
  for (;;) {
    const int id = next_item(counter, s_item);
    if (id >= 1536) break;
    if (id < 512) {
      const int qb = id & 15, head = (id >> 4) & 15, b = id >> 8;
      const int kvh = head >> 2;
      const int m0 = NP + b * LSEQ + qb * 128;
      const int s1 = (qb == 0) ? 0 : (qb - 1) * 128;
      const int e1 = (qb + 2 > 16) ? LSEQ : (qb + 2) * 128;
      attn_item<128, true>(P + (size_t)m0 * OIN + head * 128, OIN,
                           (const bf16_t*)(p.ws + OFF_KCC) + (size_t)b * 512 * 512 + kvh * 128, 512,
                           (const bf16_t*)(p.ws + OFF_VTCC) + (size_t)(b * 4 + kvh) * 128 * 512, 512, 512,
                           P + (size_t)(NP + b * LSEQ) * OIN + 2048 + kvh * 128, OIN,
                           (const bf16_t*)(p.ws + OFF_VTL) + (size_t)(b * 4 + kvh) * 128 * LP, LP, s1, e1,
                           scl2, true, p.sinks[head] * LOG2E, true, qb * 128,
                           Y + (size_t)m0 * DP + head * 128, DP, smem);
    } else {
      const int j = id - 512; const int qb = j & 1, head = (j >> 1) & 15, b = j >> 5;
      const int kvh = head >> 2;
      const int m0 = b * PSEQ + qb * 128;
      attn_item<128, true>(P + (size_t)m0 * OIN + head * 128, OIN,
                           nullptr, 0, nullptr, 0, 0,
                           P + (size_t)(b * PSEQ) * OIN + 2048 + kvh * 128, OIN,
                           (const bf16_t*)(p.ws + OFF_VTP) + (size_t)(b * 4 + kvh) * 128 * PSEQ, PSEQ, 0, PSEQ,
                           scl2, true, p.sinks[head] * LOG2E, false, 0,
                           Y + (size_t)m0 * DP + head * 128, DP, smem);
    }
  }
}


#define XB_TMO      128
#define XB_XCNT(j)  (256  + 64 * (j))
#define XB_XSUB(j)  (1280 + 64 * (j))
#define XB_XGEN(j)  (2304 + 64 * (j))
#define XB_TOP      3328
#define XB_TOPGEN   3392
#define XB_SPIN_CAP (1u << 22)
DI unsigned xb_ld(unsigned* p)              { return __hip_atomic_load(p, __ATOMIC_RELAXED, __HIP_MEMORY_SCOPE_AGENT); }
DI unsigned xb_add(unsigned* p, unsigned v) { return __hip_atomic_fetch_add(p, v, __ATOMIC_RELAXED, __HIP_MEMORY_SCOPE_AGENT); }
DI unsigned xb_xcc_id() { return (unsigned)__builtin_amdgcn_s_getreg((3 << 11) | 20) & 0xFu; }
#define XB_SPIN(cond, bar) do { unsigned _sp = 0; while (cond) { __builtin_amdgcn_s_sleep(1); \
    if ((++_sp & 255u) == 0u) { if (xb_ld(&(bar)[XB_TMO])) break; if (_sp > XB_SPIN_CAP) { atomicAdd(&(bar)[XB_TMO], 1u); break; } } } } while (0)
struct XcdBarrier { unsigned* bar; unsigned x; volatile LAS unsigned* st; };
DI XcdBarrier xcd_barrier_post(unsigned* bar, volatile LAS unsigned* st) {
  XcdBarrier b; b.bar = bar; b.x = xb_xcc_id(); b.st = st;
  if (threadIdx.x == 0) (void)xb_add(&bar[XB_XCNT(b.x)], 1u);
  return b;
}
DI void xcd_barrier_complete(unsigned* bar, unsigned x, unsigned& nloc, unsigned& nx) {
  const unsigned G = gridDim.x * gridDim.y * gridDim.z;
  unsigned sum, cnt, mine, sp = 0u;
  for (;;) {
    sum = 0u; cnt = 0u; mine = 0u;
#pragma unroll
    for (unsigned j = 0; j < 16; ++j) { const unsigned c = xb_ld(&bar[XB_XCNT(j)]); sum += c; cnt += (c > 0u) ? 1u : 0u; mine = (j == x) ? c : mine; }
    if (sum == G) break;
    __builtin_amdgcn_s_sleep(1);
    if ((++sp & 255u) == 0u) { if (xb_ld(&bar[XB_TMO])) break; if (sp > XB_SPIN_CAP) { atomicAdd(&bar[XB_TMO], 1u); break; } }
  }
  nloc = mine > 0u ? mine : 1u; nx = cnt > 0u ? cnt : 1u;
}
DI void xcd_barrier(const XcdBarrier& b) {
  asm volatile("s_waitcnt vmcnt(0)" ::: "memory");
  __syncthreads();
  if (threadIdx.x == 0) {
    unsigned* bar = b.bar;
    __builtin_amdgcn_s_waitcnt(0);
    unsigned nloc = b.st[0], nx = b.st[1];
    if (nloc == 0u) { xcd_barrier_complete(bar, b.x, nloc, nx); b.st[0] = nloc; b.st[1] = nx; }
    const unsigned old = xb_add(&bar[XB_XSUB(b.x)], 1u);
    const unsigned gen = old / nloc;
    if (old + 1u == (gen + 1u) * nloc) {
      __builtin_amdgcn_fence(__ATOMIC_RELEASE, "agent");
      asm volatile("s_waitcnt vmcnt(0)" ::: "memory");
      const unsigned og = xb_add(&bar[XB_TOP], 1u);
      const unsigned tg = og / nx;
      if (og + 1u == (tg + 1u) * nx) xb_add(&bar[XB_TOPGEN], 1u);
      else XB_SPIN(xb_ld(&bar[XB_TOPGEN]) == tg, bar);
      __builtin_amdgcn_fence(__ATOMIC_ACQUIRE, "agent");
      xb_add(&bar[XB_XGEN(b.x)], 1u);
      asm volatile("s_waitcnt vmcnt(0)" ::: "memory");
    } else {
      XB_SPIN(xb_ld(&bar[XB_XGEN(b.x)]) == gen, bar);
      __builtin_amdgcn_fence(__ATOMIC_ACQUIRE, "agent");
      asm volatile("s_waitcnt vmcnt(0)" ::: "memory");
    }
  }
  __syncthreads();
}

__global__ void __launch_bounds__(256, 2) fwd_megakernel(Params p) {
  __shared__ __attribute__((aligned(1024))) char smem[SMEM_BYTES + 16];
  int* s_item = (int*)(smem + SMEM_BYTES);
  cg::grid_group grid = cg::this_grid();
  if (p.ph_lo < 0) grid.sync();
  if (threadIdx.x == 0) { ((unsigned*)(smem + SMEM_BYTES))[2] = 0u; ((unsigned*)(smem + SMEM_BYTES))[3] = 0u; }
  __syncthreads();
  XcdBarrier xb = xcd_barrier_post((unsigned*)(p.ws + OFF_BAR), (volatile LAS unsigned*)(smem + SMEM_BYTES + 8));
  const bf16_t* H = (const bf16_t*)(p.ws + OFF_H);
#define RUN_PHASE(ph, ...) if (p.ph_lo <= (ph) && (ph) < p.ph_hi) { if ((ph) > p.ph_lo) xcd_barrier(xb); __VA_ARGS__ }
  RUN_PHASE(0, phase_prep(p, smem);)
  RUN_PHASE(1, phase_norm(p, 0, 0, true, false);)
  RUN_PHASE(2, { GemmArgs ga{H, DP, (const bf16_t*)(p.ws + OFF_WIE), DP, D, 0, 0, false}; phase_gemm<EPI_IN_EVEN>(p, ga, 48, 48, smem); })
  RUN_PHASE(3, phase_mixer_even(p, smem, s_item);)
  RUN_PHASE(4, phase_gla_chain(p);)
  RUN_PHASE(5, phase_gla_inter(p);)
  RUN_PHASE(6, phase_yprep_even(p);)
  RUN_PHASE(7, { GemmArgs ga{H, DP, (const bf16_t*)(p.ws + OFF_WOE), DP, D, 0, 0, true}; phase_gemm<EPI_RESID>(p, ga, 16, -1, smem); })
  RUN_PHASE(8, phase_norm(p, 0, 1, false, false);)
  RUN_PHASE(9, { GemmArgs ga{H, DP, (const bf16_t*)(p.ws + OFF_WFI), DP, D, 0, 0, false}; phase_gemm<EPI_SWIGLU>(p, ga, 88, -1, smem); })
  RUN_PHASE(10, { GemmArgs ga{(const bf16_t*)(p.ws + OFF_ACT), FP, (const bf16_t*)(p.ws + OFF_WFO), FP, DFF, 0, 1, false}; phase_gemm<EPI_RESID>(p, ga, 16, -1, smem); })
  RUN_PHASE(11, phase_norm(p, 1, 0, false, false);)
  RUN_PHASE(12, { GemmArgs ga{H, DP, (const bf16_t*)(p.ws + OFF_WIO), DP, D, 1, 0, false}; phase_gemm<EPI_IN_ODD>(p, ga, 24, -1, smem); })
  RUN_PHASE(13, phase_attn_odd(p, smem, s_item);)
  RUN_PHASE(14, { GemmArgs ga{H, DP, (const bf16_t*)(p.ws + OFF_WOO), DP, D, 1, 0, false}; phase_gemm<EPI_RESID>(p, ga, 16, -1, smem); })
  RUN_PHASE(15, phase_norm(p, 1, 1, false, false);)
  RUN_PHASE(16, { GemmArgs ga{H, DP, (const bf16_t*)(p.ws + OFF_WFI) + (size_t)2 * DFF * DP, DP, D, 1, 0, false}; phase_gemm<EPI_SWIGLU>(p, ga, 88, -1, smem); })
  RUN_PHASE(17, { GemmArgs ga{(const bf16_t*)(p.ws + OFF_ACT), FP, (const bf16_t*)(p.ws + OFF_WFO) + (size_t)D * FP, FP, DFF, 1, 1, false}; phase_gemm<EPI_RESID>(p, ga, 16, -1, smem); })
  RUN_PHASE(18, phase_norm(p, 0, 0, false, true);)
}

extern "C" void kernel_launch(void* const* d_in, const int* in_sizes, int n_in, void* d_out, int out_size,
                              void* d_ws, size_t ws_size, hipStream_t stream) {
  if (ws_size < WS_TOTAL) { fprintf(stderr, "workspace too small: %zu < %zu\n", ws_size, (size_t)WS_TOTAL); return; }
  static int grid_blocks = 0;
  if (!grid_blocks) {
    int dev = 0, cus = 0, per_cu = 0;
    hipGetDevice(&dev);
    hipDeviceGetAttribute(&cus, hipDeviceAttributeMultiprocessorCount, dev);
    hipOccupancyMaxActiveBlocksPerMultiprocessor(&per_cu, fwd_megakernel, 256, 0);
    if (per_cu > 2) per_cu = 2;
    if (per_cu < 1) per_cu = 1;
    grid_blocks = cus * per_cu;
  }
  Params p{};
  p.x_prompt = (const float*)d_in[0]; p.x_sample = (const float*)d_in[1]; p.c = (const float*)d_in[2];
  p.cache_a_k = (const float*)d_in[3]; p.cache_a_v = (const float*)d_in[4]; p.state_b = (const float*)d_in[5];
  p.cache_c_k = (const float*)d_in[6]; p.cache_c_v = (const float*)d_in[7]; p.c_ctx = (const float*)d_in[8];
  p.w_ada = (const float*)d_in[9]; p.b_ada = (const float*)d_in[10]; p.norm_g = (const float*)d_in[11];
  p.w_in_even = (const float*)d_in[12]; p.lam_q1 = (const float*)d_in[13]; p.lam_k1 = (const float*)d_in[14];
  p.lam_q2 = (const float*)d_in[15]; p.lam_k2 = (const float*)d_in[16]; p.subln_g = (const float*)d_in[17];
  p.w_gate1 = (const float*)d_in[18]; p.w_gate2 = (const float*)d_in[19]; p.b_gate = (const float*)d_in[20];
  p.gla_norm_g = (const float*)d_in[21]; p.w_out_even = (const float*)d_in[22]; p.w_in_odd = (const float*)d_in[23];
  p.sinks = (const float*)d_in[24]; p.w_out_odd = (const float*)d_in[25]; p.w_ffn_in = (const float*)d_in[26];
  p.w_ffn_out = (const float*)d_in[27]; p.final_norm_g = (const float*)d_in[28];
  p.out = (float*)d_out; p.ws = (char*)d_ws;
  p.ph_lo = 0; p.ph_hi = 19;
  hipMemsetAsync(d_ws, 0, ZERO_BYTES, stream);
  void* args[] = {&p};
  hipError_t e = hipLaunchCooperativeKernel((void*)fwd_megakernel, dim3(grid_blocks), dim3(256), args, 0, stream);
  if (e != hipSuccess) fprintf(stderr, "cooperative launch failed: %s (grid %d)\n", hipGetErrorString(e), grid_blocks);
}
```
